# Optimizing an MI355X kernel written in HIP

```python
import jax
import jax.numpy as jnp
from jax import lax
import numpy as np


D_MODEL = 1024
BATCH = 8
SEQ = 4096
DEPTH = 4

N_MIXERS = 2
N_A_LAYERS = (DEPTH + 1) // 2
N_B_LAYERS = DEPTH // 2

HG_EXPAND = 128
HG_HEADS = D_MODEL // HG_EXPAND
HG_KDIM = HG_EXPAND
HG_VDIM = D_MODEL // HG_HEADS
HG_CHUNK = 32

ATT_HEAD_DIM = 128
ATT_HEADS = D_MODEL // ATT_HEAD_DIM
DILATED_GROUPS = ((128, 1), (512, 4), (2048, 16))
N_GROUPS = len(DILATED_GROUPS)
ATT_QKV_COLS = N_GROUPS * 3 * ATT_HEADS * ATT_HEAD_DIM
ROPE_THETA = 500000.0
ROPE_DIM = ATT_HEAD_DIM // 4

D_FF = -(-(8 * D_MODEL) // (3 * 256)) * 256

NORM_EPS = 1e-6

kernel_name = 'hybrid_hgrn2_dilated_attn_block'


def rms_norm(x, g):
    xf = x.astype(jnp.float32)
    y = xf * lax.rsqrt(jnp.mean(xf * xf, axis=-1, keepdims=True) + NORM_EPS)
    return (y * g.astype(jnp.float32)).astype(x.dtype)


def apply_partial_rope(t, cos, sin):
    half = ROPE_DIM // 2
    t1 = t[..., :half]
    t2 = t[..., half:ROPE_DIM]
    return jnp.concatenate([t1 * cos - t2 * sin, t2 * cos + t1 * sin, t[..., ROPE_DIM:]], axis=-1)


def hgrn2_mixer(u, w_in, lb, norm_g, w_out):
    B, S, _ = u.shape
    H, K, C = HG_HEADS, HG_KDIM, HG_CHUNK
    proj = (u @ w_in).astype(jnp.float32).reshape(B, S, 4, H, K)
    q_raw, f_raw, v, g = proj[:, :, 0], proj[:, :, 1], proj[:, :, 2], proj[:, :, 3]
    lb = lb.astype(jnp.float32).reshape(H, K)
    log_f = jnp.log(lb + (1.0 - lb) * jax.nn.sigmoid(f_raw))
    k = (1.0 - lb) * jax.nn.sigmoid(-f_raw)
    q = jax.nn.silu(q_raw)
    NC = S // C
    rs = lambda t: t.reshape(B, NC, C, H, t.shape[-1])
    q, k, v, log_f = rs(q), rs(k), rs(v), rs(log_f)
    b = jnp.cumsum(log_f, axis=2)
    q_dec = q * jnp.exp(b)
    k_inv = k * jnp.exp(-b)
    causal = jnp.tril(jnp.ones((C, C), dtype=bool))
    a = jnp.einsum('bnchk,bnshk->bnhcs', q_dec, k_inv)
    a = jnp.where(causal, a, 0.0)
    o_intra = jnp.einsum('bnhcs,bnshv->bnchv', a, v)
    b_last = b[:, :, -1:]
    k_end = k * jnp.exp(b_last - b)
    chunk_decay = jnp.exp(b_last[:, :, 0])

    def step(state, xs):
        q_c, k_c, v_c, dec = xs
        o_c = jnp.einsum('bchk,bhkv->bchv', q_c, state)
        state = dec[..., None] * state + jnp.einsum('bchk,bchv->bhkv', k_c, v_c)
        return state, o_c

    xs = (jnp.moveaxis(q_dec, 1, 0), jnp.moveaxis(k_end, 1, 0),
          jnp.moveaxis(v, 1, 0), jnp.moveaxis(chunk_decay, 1, 0))
    state0 = jnp.zeros((B, H, K, HG_VDIM), jnp.float32)
    _, o_inter = lax.scan(step, state0, xs)
    o = (o_intra + jnp.moveaxis(o_inter, 0, 1)).reshape(B, S, H, HG_VDIM)
    o = o * lax.rsqrt(jnp.mean(o * o, axis=-1, keepdims=True) + NORM_EPS)
    o = o * norm_g.astype(jnp.float32).reshape(H, HG_VDIM)
    o = o.reshape(B, S, D_MODEL) * jax.nn.silu(g.reshape(B, S, D_MODEL))
    return o.astype(u.dtype) @ w_out


def dilated_group_attention(q, k, v, window, dilation):
    B, S, H, Dh = q.shape
    L = S // dilation
    n_win = window // dilation
    blk = n_win
    nb = -(-L // blk)
    Lp = nb * blk

    def gather(t):
        t = t.reshape(B, L, dilation, H, Dh).transpose(0, 2, 1, 3, 4).reshape(B * dilation, L, H, Dh)
        t = jnp.pad(t, ((0, 0), (0, Lp - L), (0, 0), (0, 0)))
        return t.reshape(B * dilation, nb, blk, H, Dh)

    def with_prev(t):
        prev = jnp.pad(t, ((0, 0), (1, 0), (0, 0), (0, 0), (0, 0)))[:, :-1]
        return jnp.concatenate([prev, t], axis=2)

    qb = gather(q)
    kw = with_prev(gather(k))
    vw = with_prev(gather(v))
    s = jnp.einsum('bnqhd,bnkhd->bnhqk', qb, kw)
    qi = jnp.arange(blk)[:, None]
    ki = jnp.arange(2 * blk)[None, :]
    dist = blk + qi - ki
    band = (dist >= 0) & (dist <= n_win)
    has_prev = (jnp.arange(nb)[:, None, None] > 0) | (ki >= blk)[None]
    valid = band[None] & has_prev
    s = jnp.where(valid[None, :, None], s, -jnp.inf)
    m = jnp.max(s, axis=-1, keepdims=True)
    p = jnp.exp(s - m)
    z = jnp.sum(p, axis=-1, keepdims=True)
    o = jnp.einsum('bnhqk,bnkhd->bnqhd', p, vw) / jnp.swapaxes(z, 2, 3)
    lse = jnp.swapaxes((m + jnp.log(z))[..., 0], 2, 3)

    def scatter_back(t):
        rest = t.shape[3:]
        t = t.reshape(B, dilation, Lp, *rest)[:, :, :L]
        return jnp.moveaxis(t, 1, 2).reshape(B, S, *rest)

    return scatter_back(o), scatter_back(lse)


def dilated_attention_mixer(u, cos, sin, w_in, w_out):
    B, S, _ = u.shape
    proj = (u @ w_in).astype(jnp.float32).reshape(B, S, N_GROUPS, 3, ATT_HEADS, ATT_HEAD_DIM)
    scale = ATT_HEAD_DIM ** -0.5
    outs = []
    lses = []
    for gi, (window, dilation) in enumerate(DILATED_GROUPS):
        q = apply_partial_rope(proj[:, :, gi, 0], cos, sin) * scale
        k = apply_partial_rope(proj[:, :, gi, 1], cos, sin)
        v = proj[:, :, gi, 2]
        o_g, lse_g = dilated_group_attention(q, k, v, window, dilation)
        outs.append(o_g)
        lses.append(lse_g)
    wts = jax.nn.softmax(jnp.stack(lses, axis=0), axis=0)
    o = jnp.einsum('gbsh,gbshd->bshd', wts, jnp.stack(outs, axis=0))
    return o.reshape(B, S, D_MODEL).astype(u.dtype) @ w_out


def swiglu_ffn(u, w_in, w_out):
    gate, up = jnp.split(u @ w_in, 2, axis=-1)
    return (jax.nn.silu(gate) * up) @ w_out


def setup_inputs(seed: int = 0) -> dict:
    key = jax.random.key(seed)
    ks = jax.random.split(key, 16)
    D = D_MODEL
    nrm = jax.random.normal
    x = nrm(ks[0], (BATCH, SEQ, D), jnp.float32)
    c = nrm(ks[1], (BATCH, D), jnp.float32)
    offset = jax.random.randint(ks[2], (BATCH, 1), 0, 1024, dtype=jnp.int32)
    positions = offset + jnp.arange(SEQ, dtype=jnp.int32)[None, :]
    ada_w = nrm(ks[3], (DEPTH, D, 6 * D), jnp.float32) * (0.5 * D ** -0.5)
    ada_b = nrm(ks[4], (DEPTH, 6 * D), jnp.float32) * 0.02
    norm_g = 1.0 + 0.05 * nrm(ks[5], (DEPTH, 4, D), jnp.float32)
    hgrn_w_in = nrm(ks[6], (N_A_LAYERS, D, 4 * D), jnp.float32) * D ** -0.5
    hgrn_lower_bounds = 1.0 + 0.5 * nrm(ks[7], (N_A_LAYERS, D), jnp.float32)
    hgrn_norm_g = 1.0 + 0.05 * nrm(ks[8], (N_A_LAYERS, D), jnp.float32)
    hgrn_w_out = nrm(ks[9], (N_A_LAYERS, D, D), jnp.float32) * D ** -0.5
    attn_w_in = nrm(ks[10], (N_B_LAYERS, D, ATT_QKV_COLS), jnp.float32) * D ** -0.5
    attn_w_out = nrm(ks[11], (N_B_LAYERS, D, D), jnp.float32) * D ** -0.5
    ffn_w_in = nrm(ks[12], (DEPTH, D, 2 * D_FF), jnp.float32) * D ** -0.5
    ffn_w_out = nrm(ks[13], (DEPTH, D_FF, D), jnp.float32) * D_FF ** -0.5
    return {'x': x, 'c': c, 'positions': positions, 'ada_w': ada_w, 'ada_b': ada_b,
            'norm_g': norm_g, 'hgrn_w_in': hgrn_w_in, 'hgrn_lower_bounds': hgrn_lower_bounds,
            'hgrn_norm_g': hgrn_norm_g, 'hgrn_w_out': hgrn_w_out, 'attn_w_in': attn_w_in,
            'attn_w_out': attn_w_out, 'ffn_w_in': ffn_w_in, 'ffn_w_out': ffn_w_out}


def reference(x, c, positions, ada_w, ada_b, norm_g, hgrn_w_in, hgrn_lower_bounds,
              hgrn_norm_g, hgrn_w_out, attn_w_in, attn_w_out, ffn_w_in, ffn_w_out):
    cond = jax.nn.silu(c)
    inv_freq = ROPE_THETA ** (-jnp.arange(0, ROPE_DIM, 2, dtype=jnp.float32) / ROPE_DIM)
    ang = positions.astype(jnp.float32)[..., None] * inv_freq
    cos = jnp.cos(ang)[:, :, None, :]
    sin = jnp.sin(ang)[:, :, None, :]
    lbs = jnp.cumsum(jax.nn.softmax(hgrn_lower_bounds.astype(jnp.float32), axis=0), axis=0)
    lbs = lbs - lbs[0:1]
    h = x
    for layer in range(DEPTH):
        mod = (cond @ ada_w[layer] + ada_b[layer])[:, None, :]
        sh1, sc1, g1, sh2, sc2, g2 = jnp.split(mod, 6, axis=-1)
        u = rms_norm(h, norm_g[layer, 0]) * (1.0 + sc1) + sh1
        idx = layer // N_MIXERS
        if layer % N_MIXERS == 0:
            y = hgrn2_mixer(u, hgrn_w_in[idx], lbs[idx], hgrn_norm_g[idx], hgrn_w_out[idx])
        else:
            y = dilated_attention_mixer(u, cos, sin, attn_w_in[idx], attn_w_out[idx])
        h = h + (1.0 + g1) * rms_norm(y, norm_g[layer, 1])
        u = rms_norm(h, norm_g[layer, 2]) * (1.0 + sc2) + sh2
        y = swiglu_ffn(u, ffn_w_in[layer], ffn_w_out[layer])
        h = h + (1.0 + g2) * rms_norm(y, norm_g[layer, 3])
    return h
```

```cpp
#include <hip/hip_runtime.h>
#include <hip/hip_cooperative_groups.h>
#include <cstdio>
#include <cstdint>
namespace cg = cooperative_groups;
namespace pg8 {
#define PG8_LAS __attribute__((address_space(3)))
typedef unsigned short bf16_t;
typedef short bf16x8 __attribute__((ext_vector_type(8)));
typedef float f32x4 __attribute__((ext_vector_type(4)));
typedef unsigned u32x4 __attribute__((ext_vector_type(4)));
constexpr int BM = 256, BK = 64, HALF = 128, HTB = HALF * BK * 2  , STAGE_BYTES = 8 * HTB, NXCD = 8, WGM = 8;

__host__ __device__ __forceinline__ int lds_byte(int r, int c) { const int st = (r >> 4) * 2 + (c >> 5), rr = r & 15, cc = c & 31, ob = rr * 64 + cc * 2; return st * 1024 + (ob ^ (((ob >> 9) & 1) << 5)); }
__host__ __device__ __forceinline__ void stage_rc(int b, int& R, int& C) { const int st = b / 1024, sb = b % 1024, swz = sb ^ (((sb >> 9) & 1) << 5); R = (st >> 1) * 16 + swz / 64; C = (st & 1) * 32 + (swz % 64) / 2; }
__host__ __device__ __forceinline__ int perm32(int rho) { const int n = rho >> 4, i = rho & 15; return 8 * (i >> 2) + 4 * n + (i & 3); }

struct Unit { int pm, pn; };
struct Gemm { const bf16_t* A; const bf16_t* Bt; int M, N, K; };

struct StaticOrder {
    int nM, nN, nwg, G, c;
    __host__ __device__ void init(int M, int N, int G_, int c_) { nM = M / BM; nN = N / BM; nwg = nM * nN; G = G_; c = c_; }
    __host__ __device__ bool next(int i, Unit& u) const {
        const long L = (long)i * G + c; if (L >= nwg) return false;
        int wgid = (int)L; { const int q = nwg / NXCD, r = nwg % NXCD, xcd = wgid % NXCD, off = wgid / NXCD; wgid = (xcd < r ? xcd * (q + 1) : r * (q + 1) + (xcd - r) * q) + off; }
        const int nig = WGM * nN, gid = wgid / nig, fm = gid * WGM, gsz = (nM - fm) < WGM ? (nM - fm) : WGM;
        u.pm = fm + ((wgid % nig) % gsz); u.pn = (wgid % nig) / gsz; return true;
    }
    __device__ __forceinline__ void a_ready(const Unit&) const {}
    __device__ __forceinline__ void done(const Unit&) const {}
};

typedef float f32x2 __attribute__((ext_vector_type(2)));
typedef __bf16 bf16x2_t __attribute__((ext_vector_type(2)));
typedef unsigned u32x2 __attribute__((ext_vector_type(2)));
__device__ __forceinline__ unsigned cvt_pk_bf16(float lo, float hi) { unsigned r; asm volatile("v_cvt_pk_bf16_f32 %0, %1, %2" : "=v"(r) : "v"(lo), "v"(hi)); return r; }
__device__ __forceinline__ unsigned cvt_pk_bf16_c(float lo, float hi) { f32x2 v = {lo, hi}; bf16x2_t b = __builtin_convertvector(v, bf16x2_t); return __builtin_bit_cast(unsigned, b); }
__device__ __forceinline__ float silu_f(float x) { return x * __builtin_amdgcn_rcpf(1.0f + __expf(-x)); }
__device__ __forceinline__ u32x4 pack8(const f32x4& a, const f32x4& b) { u32x4 w; w.x = cvt_pk_bf16(a[0], a[1]); w.y = cvt_pk_bf16(a[2], a[3]); w.z = cvt_pk_bf16(b[0], b[1]); w.w = cvt_pk_bf16(b[2], b[3]); return w; }
__device__ __forceinline__ u32x2 pack4(const f32x4& a) { u32x2 w; w.x = cvt_pk_bf16(a[0], a[1]); w.y = cvt_pk_bf16(a[2], a[3]); return w; }

struct EpiPlain {
    static constexpr bool PERM = true, AFTER_DRAIN = false;
    bf16_t* O; int ldc;
    __device__ __forceinline__ void operator()(const f32x4 (&acc)[2][2][4][2], const Unit& u, int wr, int wc, int fr, int fq) const {
        const int row0 = u.pm * BM + wr * 64 + fr, col0 = u.pn * BM + wc * 32 + 8 * fq;
#pragma unroll
        for (int ai = 0; ai < 2; ++ai)
#pragma unroll
            for (int m = 0; m < 4; ++m) { bf16_t* rowp = O + (size_t)(row0 + ai * HALF + m * 16) * ldc + col0;
#pragma unroll
                for (int bj = 0; bj < 2; ++bj) *(u32x4*)(rowp + bj * HALF) = pack8(acc[ai][bj][m][0], acc[ai][bj][m][1]); }
    }
};
struct EpiSwiglu {
    static constexpr bool PERM = true, AFTER_DRAIN = false;
    bf16_t* H; int ldc;
    __device__ __forceinline__ void operator()(const f32x4 (&acc)[2][2][4][2], const Unit& u, int wr, int wc, int fr, int fq) const {
        const int row0 = u.pm * BM + wr * 64 + fr, col0 = u.pn * HALF + wc * 32 + 8 * fq;
#pragma unroll
        for (int ai = 0; ai < 2; ++ai)
#pragma unroll
            for (int m = 0; m < 4; ++m) { f32x4 r0, r1;
#pragma unroll
                for (int i = 0; i < 4; ++i) { r0[i] = silu_f(acc[ai][0][m][0][i]) * acc[ai][1][m][0][i]; r1[i] = silu_f(acc[ai][0][m][1][i]) * acc[ai][1][m][1][i]; }
                *(u32x4*)(H + (size_t)(row0 + ai * HALF + m * 16) * ldc + col0) = pack8(r0, r1); }
    }
};
struct EpiRope {
    static constexpr bool PERM = false, AFTER_DRAIN = false;
    bf16_t* QKV; size_t tstride; const float* cs; const float* sn;
    __device__ __forceinline__ void operator()(const f32x4 (&acc)[2][2][4][2], const Unit& u, int wr, int wc, int fr, int fq) const {
        const int t = u.pn >> 2; bf16_t* base = QKV + (size_t)t * tstride;
        const int row0 = u.pm * BM + wr * 64 + fr, col0 = (u.pn & 3) * BM + wc * 32 + 4 * fq;
        const bool rope = (t < 2) && (wc == 0); const float scale = (t == 0) ? 0.08838834764831845f : 1.0f;
#pragma unroll
        for (int ai = 0; ai < 2; ++ai)
#pragma unroll
            for (int m = 0; m < 4; ++m) { const int row = row0 + ai * HALF + m * 16; f32x4 c4 = {1.f, 1.f, 1.f, 1.f}, s4 = {0.f, 0.f, 0.f, 0.f};
                if (rope) { c4 = *(const f32x4*)(cs + (size_t)row * 16 + 4 * fq); s4 = *(const f32x4*)(sn + (size_t)row * 16 + 4 * fq); }
#pragma unroll
                for (int bj = 0; bj < 2; ++bj) { f32x4 v0 = acc[ai][bj][m][0], v1 = acc[ai][bj][m][1];
                    const f32x4 n0 = (v0 * c4 - v1 * s4) * scale, n1 = (v1 * c4 + v0 * s4) * scale;
                    bf16_t* p = base + (size_t)row * 1024 + col0 + bj * HALF;
                    *(u32x2*)p = pack4(n0); *(u32x2*)(p + 16) = pack4(n1); } }
    }
};
#define DPP_SHR(x, n) __builtin_bit_cast(float, __builtin_amdgcn_update_dpp(0, __builtin_bit_cast(int, (x)), 0x110 + (n), 0xf, 0xf, false))
__device__ __forceinline__ float row_scan16(float x) { x += DPP_SHR(x, 1); x += DPP_SHR(x, 2); x += DPP_SHR(x, 4); x += DPP_SHR(x, 8); return x; }
struct EpiHgrn {
    static constexpr bool PERM = true, AFTER_DRAIN = false;
    bf16_t *QD, *KI, *VV, *GG; float* DEC; const float* lb;
    __device__ __forceinline__ void operator()(const f32x4 (&acc)[2][2][4][2], const Unit& u, int wr, int wc, int fr, int fq) const {
        const int row0 = u.pm * BM + wr * 64 + fr;
        if (u.pn >= 8) {
            bf16_t* base = (u.pn >= 12) ? GG : VV; const int col0 = (u.pn & 3) * BM + wc * 32 + 8 * fq;
#pragma unroll
            for (int ai = 0; ai < 2; ++ai)
#pragma unroll
                for (int m = 0; m < 4; ++m) { bf16_t* rowp = base + (size_t)(row0 + ai * HALF + m * 16) * 1024 + col0;
#pragma unroll
                    for (int bj = 0; bj < 2; ++bj) *(u32x4*)(rowp + bj * HALF) = pack8(acc[ai][bj][m][0], acc[ai][bj][m][1]); }
            return;
        }
        const int col0 = u.pn * HALF + wc * 32 + 8 * fq;
        const f32x4 lb0 = *(const f32x4*)(lb + col0), lb1 = *(const f32x4*)(lb + col0 + 4);
        const int lane15 = (threadIdx.x & 48) | 15;
#pragma unroll
        for (int ai = 0; ai < 2; ++ai)
#pragma unroll
            for (int mp = 0; mp < 2; ++mp) {
                const int ra = row0 + ai * HALF + mp * 32, rb = ra + 16;
                f32x4 qa[2], qb[2], ka[2], kb[2], dc[2];
#pragma unroll
                for (int n = 0; n < 2; ++n)
#pragma unroll
                    for (int i = 0; i < 4; ++i) {
                        const float lbv = n ? lb1[i] : lb0[i], oml = 1.0f - lbv;
                        const float fa = acc[ai][1][2 * mp][n][i], fb = acc[ai][1][2 * mp + 1][n][i];
                        const float ta = __expf(-fabsf(fa)), ra_ = __builtin_amdgcn_rcpf(1.0f + ta), sa = fa >= 0.f ? ra_ : ta * ra_, na = fa >= 0.f ? ta * ra_ : ra_;
                        const float tb = __expf(-fabsf(fb)), rb_ = __builtin_amdgcn_rcpf(1.0f + tb), sb = fb >= 0.f ? rb_ : tb * rb_, nb = fb >= 0.f ? tb * rb_ : rb_;
                        const float la = __logf(lbv + oml * sa), lbg = __logf(lbv + oml * sb);
                        const float ca = row_scan16(la), cb0 = row_scan16(lbg);
                        const float tota = __shfl(ca, lane15), totb = __shfl(cb0, lane15);
                        const float ba = ca, bb = tota + cb0, bl = tota + totb;
                        qa[n][i] = silu_f(acc[ai][0][2 * mp][n][i]) * __expf(ba); qb[n][i] = silu_f(acc[ai][0][2 * mp + 1][n][i]) * __expf(bb);
                        ka[n][i] = oml * na * __expf(-ba); kb[n][i] = oml * nb * __expf(-bb); dc[n][i] = __expf(bl);
                    }
                *(u32x4*)(QD + (size_t)ra * 1024 + col0) = pack8(qa[0], qa[1]); *(u32x4*)(QD + (size_t)rb * 1024 + col0) = pack8(qb[0], qb[1]);
                *(u32x4*)(KI + (size_t)ra * 1024 + col0) = pack8(ka[0], ka[1]); *(u32x4*)(KI + (size_t)rb * 1024 + col0) = pack8(kb[0], kb[1]);
                if (fr == 0) { float* dp = DEC + (size_t)(ra >> 5) * 1024 + col0; *(f32x4*)dp = dc[0]; *(f32x4*)(dp + 4) = dc[1]; }
            }
    }
};

template <class Epi, class Sched, bool ALIGN_EPI = false, bool SP2 = false>
__device__ __forceinline__ void gemm_phase(PG8_LAS unsigned char* lds, const Gemm g, const Sched& S, const Epi& E) {
    int tid_o = threadIdx.x; asm volatile("" : "+v"(tid_o)); const int tid = tid_o, wid = __builtin_amdgcn_readfirstlane(tid >> 6), lane = tid & 63, wr = wid >> 2, wc = wid & 3, fr = lane & 15, fq = lane >> 4;
    const int K = g.K, nt = K / BK;
    unsigned voffA[2], voffB[2];
#pragma unroll
    for (int i = 0; i < 2; ++i) { int R, C; stage_rc(tid * 16 + i * 8192, R, C); const int Rb = Epi::PERM ? ((R & ~31) + perm32(R & 31)) : R;
        voffA[i] = (unsigned)(R * K + C) * 2u; voffB[i] = (unsigned)(Rb * K + C) * 2u; }
    const size_t kstep = (size_t)(BK * 2);
    const size_t hstep = (size_t)HALF * K * 2;
    const size_t tstep = 2 * hstep;
    const unsigned ldsw = (unsigned)wid * 1024u;
    const int aoff = lds_byte(wr * 64 + fr, fq * 8), boff = lds_byte(wc * 32 + fr, fq * 8);
#define PG8_SA(b, h) (((b) * 2 + (h)) * HTB)
#define PG8_SB(b, h) ((4 + (b) * 2 + (h)) * HTB)
#define PG8_STAGE(bufoff, gbase, voff) do { _Pragma("unroll") for (int _i = 0; _i < 2; ++_i) \
        __builtin_amdgcn_global_load_lds((const unsigned*)((const char*)(gbase) + (voff)[_i]), (PG8_LAS unsigned*)(lds + (bufoff) + ldsw + _i * 8192), 16, 0, 0); } while (0)
#define PG8_LDA(dst, b, h) do { _Pragma("unroll") for (int m = 0; m < 4; ++m) _Pragma("unroll") for (int k = 0; k < 2; ++k) dst[m][k] = *(const PG8_LAS bf16x8*)(lds + PG8_SA(b, h) + aoff + m * 2048 + k * 1024); } while (0)
#define PG8_LDB(dst, b, h) do { _Pragma("unroll") for (int n = 0; n < 2; ++n) _Pragma("unroll") for (int k = 0; k < 2; ++k) dst[n][k] = *(const PG8_LAS bf16x8*)(lds + PG8_SB(b, h) + boff + n * 2048 + k * 1024); } while (0)
#define PG8_MMA(ai, bj, At, Bt) do { __builtin_amdgcn_s_setprio(1); _Pragma("unroll") for (int m = 0; m < 4; ++m) _Pragma("unroll") for (int n = 0; n < 2; ++n) _Pragma("unroll") for (int k = 0; k < 2; ++k) \
        acc[ai][bj][m][n] = __builtin_amdgcn_mfma_f32_16x16x32_bf16(Bt[n][k], At[m][k], acc[ai][bj][m][n], 0, 0, 0); __builtin_amdgcn_s_setprio(0); } while (0)
#define PG8_WAIT_V(n) asm volatile("s_waitcnt vmcnt(" #n ")" ::: "memory")
#define PG8_WAIT_L(n) asm volatile("s_waitcnt lgkmcnt(" #n ")" ::: "memory")
#define PG8_BAR __builtin_amdgcn_s_barrier()
#define PG8_SCHED __builtin_amdgcn_sched_barrier(0)
    Unit cur, nxt; int ui = 0;
    if (!S.next(0, cur)) return;
    f32x4 acc[2][2][4][2];
#pragma unroll
    for (int a = 0; a < 2; ++a)
#pragma unroll
        for (int b = 0; b < 2; ++b)
#pragma unroll
            for (int m = 0; m < 4; ++m)
#pragma unroll
                for (int n = 0; n < 2; ++n) acc[a][b][m][n] = (f32x4){0.f, 0.f, 0.f, 0.f};
    bf16x8 At[4][2], B0[2][2], B1[2][2];
    const char* cA = (const char*)g.A + (size_t)cur.pm * tstep; const char* cB = (const char*)g.Bt + (size_t)cur.pn * tstep;
    S.a_ready(cur);
    if constexpr (SP2) {
        PG8_STAGE(PG8_SB(0, 0), cB, voffB); PG8_STAGE(PG8_SB(0, 1), cB + hstep, voffB); PG8_STAGE(PG8_SA(0, 0), cA, voffA); PG8_STAGE(PG8_SA(0, 1), cA + hstep, voffA);
        if (wr == 1) PG8_BAR;
        PG8_WAIT_V(2); PG8_BAR;
        PG8_STAGE(PG8_SB(1, 0), cB + kstep, voffB); PG8_STAGE(PG8_SA(1, 0), cA + kstep, voffA); PG8_STAGE(PG8_SB(1, 1), cB + hstep + kstep, voffB);
        PG8_WAIT_V(6); PG8_BAR;
    } else {
        PG8_STAGE(PG8_SB(0, 0), cB, voffB); PG8_STAGE(PG8_SA(0, 0), cA, voffA); PG8_STAGE(PG8_SB(0, 1), cB + hstep, voffB); PG8_STAGE(PG8_SA(0, 1), cA + hstep, voffA);
        if (wr == 1) PG8_BAR;
        PG8_WAIT_V(4); PG8_BAR;
        PG8_STAGE(PG8_SB(1, 0), cB + kstep, voffB); PG8_STAGE(PG8_SA(1, 0), cA + kstep, voffA); PG8_STAGE(PG8_SB(1, 1), cB + hstep + kstep, voffB);
        PG8_WAIT_V(6); PG8_BAR;
    }
    for (;;) {
        const bool has_next = S.next(ui + 1, nxt);
        const char* nA = has_next ? (const char*)g.A + (size_t)nxt.pm * tstep : cA; const char* nB = has_next ? (const char*)g.Bt + (size_t)nxt.pn * tstep : cB;
        for (int t = 0; t < nt; t += 2) {
            const bool last = (t == nt - 2);
            const char* a1 = cA + (size_t)(t + 1) * kstep;
            const char* a2 = last ? nA : cA + (size_t)(t + 2) * kstep; const char* b2 = last ? nB : cB + (size_t)(t + 2) * kstep;
            const char* a3 = a2 + kstep; const char* b3 = b2 + kstep;
            if (last && has_next) S.a_ready(nxt);
            if constexpr (SP2) {
            PG8_LDB(B0, 0, 0); PG8_LDB(B1, 0, 1); PG8_SCHED; PG8_LDA(At, 0, 0); PG8_STAGE(PG8_SA(1, 1), a1 + hstep, voffA);
            PG8_WAIT_V(8); PG8_WAIT_L(0); PG8_BAR; PG8_MMA(0, 0, At, B0); PG8_MMA(0, 1, At, B1); PG8_BAR; PG8_SCHED;
            PG8_LDA(At, 0, 1); PG8_STAGE(PG8_SB(0, 0), b2, voffB); PG8_STAGE(PG8_SB(0, 1), b2 + hstep, voffB); PG8_STAGE(PG8_SA(0, 0), a2, voffA);
            PG8_WAIT_V(8); PG8_WAIT_L(0); PG8_BAR; PG8_MMA(1, 0, At, B0); PG8_MMA(1, 1, At, B1); PG8_BAR; PG8_SCHED;
            PG8_LDB(B0, 1, 0); PG8_LDB(B1, 1, 1); PG8_SCHED; PG8_LDA(At, 1, 0); PG8_STAGE(PG8_SA(0, 1), a2 + hstep, voffA);
            PG8_WAIT_V(8); PG8_WAIT_L(0); PG8_BAR; PG8_MMA(0, 0, At, B0); PG8_MMA(0, 1, At, B1); PG8_BAR; PG8_SCHED;
            PG8_LDA(At, 1, 1); PG8_STAGE(PG8_SB(1, 0), b3, voffB); PG8_STAGE(PG8_SB(1, 1), b3 + hstep, voffB); PG8_STAGE(PG8_SA(1, 0), a3, voffA);
            PG8_WAIT_V(8); PG8_WAIT_L(0); PG8_BAR; PG8_MMA(1, 0, At, B0); PG8_MMA(1, 1, At, B1); PG8_BAR; PG8_SCHED;
            } else {
            PG8_LDB(B0, 0, 0); PG8_SCHED; PG8_LDA(At, 0, 0); PG8_STAGE(PG8_SA(1, 1), a1 + hstep, voffA);
            PG8_WAIT_L(8); PG8_BAR; PG8_WAIT_L(0); PG8_MMA(0, 0, At, B0); PG8_BAR; PG8_SCHED;
            PG8_LDB(B1, 0, 1); PG8_STAGE(PG8_SB(0, 0), b2, voffB);
            PG8_BAR; PG8_WAIT_L(0); PG8_MMA(0, 1, At, B1); PG8_BAR;
            PG8_LDA(At, 0, 1); PG8_STAGE(PG8_SA(0, 0), a2, voffA);
            PG8_BAR; PG8_WAIT_L(0); PG8_MMA(1, 0, At, B0); PG8_BAR; PG8_SCHED;
            PG8_STAGE(PG8_SB(0, 1), b2 + hstep, voffB);
            PG8_WAIT_V(6); PG8_BAR; PG8_MMA(1, 1, At, B1); PG8_BAR;
            PG8_LDB(B0, 1, 0); PG8_SCHED; PG8_LDA(At, 1, 0); PG8_STAGE(PG8_SA(0, 1), a2 + hstep, voffA);
            PG8_WAIT_L(8); PG8_BAR; PG8_WAIT_L(0); PG8_MMA(0, 0, At, B0); PG8_BAR; PG8_SCHED;
            PG8_LDB(B1, 1, 1); PG8_STAGE(PG8_SB(1, 0), b3, voffB);
            PG8_BAR; PG8_WAIT_L(0); PG8_MMA(0, 1, At, B1); PG8_BAR;
            PG8_LDA(At, 1, 1); PG8_STAGE(PG8_SA(1, 0), a3, voffA);
            PG8_BAR; PG8_WAIT_L(0); PG8_MMA(1, 0, At, B0); PG8_BAR; PG8_SCHED;
            PG8_STAGE(PG8_SB(1, 1), b3 + hstep, voffB);
            PG8_WAIT_V(6); PG8_BAR; PG8_MMA(1, 1, At, B1); PG8_BAR;
            }
        }
        if constexpr (ALIGN_EPI) { if (wr == 0) PG8_BAR; }
        if constexpr (!Epi::AFTER_DRAIN) { E(acc, cur, wr, wc, fr, fq); S.done(cur); }
        if (!has_next) break;
#pragma unroll
        for (int a = 0; a < 2; ++a)
#pragma unroll
            for (int b = 0; b < 2; ++b)
#pragma unroll
                for (int m = 0; m < 4; ++m)
#pragma unroll
                    for (int n = 0; n < 2; ++n) acc[a][b][m][n] = (f32x4){0.f, 0.f, 0.f, 0.f};
        cur = nxt; cA = nA; cB = nB; ++ui;
        if constexpr (ALIGN_EPI) { if (wr == 1) PG8_BAR; }
    }
    PG8_WAIT_V(0);
    if constexpr (!ALIGN_EPI) { if (wr == 0) PG8_BAR; }
    PG8_BAR;
    if constexpr (Epi::AFTER_DRAIN) { E.fused(acc, cur, wr, wc, fr, fq, lds, wid, lane); S.done(cur); }
#undef PG8_SA
#undef PG8_SB
#undef PG8_STAGE
#undef PG8_LDA
#undef PG8_LDB
#undef PG8_MMA
#undef PG8_WAIT_V
#undef PG8_WAIT_L
#undef PG8_BAR
#undef PG8_SCHED
}
}

#define LAS __attribute__((address_space(3)))
typedef unsigned short bf16;
typedef unsigned v4u __attribute__((ext_vector_type(4)));
typedef unsigned v2u __attribute__((ext_vector_type(2)));
typedef float f32x4 __attribute__((ext_vector_type(4)));
typedef short bf16x8 __attribute__((ext_vector_type(8)));
typedef short s16x4 __attribute__((ext_vector_type(4)));
typedef short v4i16_t __attribute__((ext_vector_type(4)));
constexpr int BATCH = 8, SEQ = 4096, D = 1024, M = BATCH * SEQ, DFF = 2816, NH = 8, HD = 128, DEPTH = 4;
constexpr float EPS = 1e-6f;
constexpr size_t MiB = 1u << 20;
constexpr size_t WS_MOD = 1 * MiB;
constexpr size_t WS_LB = WS_MOD + 4 * 8 * 6144 * 4;
constexpr size_t WS_ROPE = 2 * MiB;
constexpr size_t WS_LSE = 6 * MiB;
constexpr size_t WS_W = 8 * MiB;
constexpr size_t W_HIN = WS_W, W_HOUT = WS_W + 16 * MiB, W_AIN = WS_W + 20 * MiB, W_AOUT = WS_W + 56 * MiB, W_FIN = WS_W + 60 * MiB, W_FOUT = WS_W + 104 * MiB;
constexpr size_t WS_U = 134 * MiB;
constexpr size_t WS_R = 198 * MiB;
constexpr size_t WS_END = 458 * MiB;
constexpr int LDS_BYTES = 147456;
constexpr int NWAVES = 8;

__device__ __forceinline__ unsigned pk2(float lo, float hi) { return pg8::cvt_pk_bf16(lo, hi); }
__device__ __forceinline__ float bflo(unsigned w) { return __builtin_bit_cast(float, w << 16); }
__device__ __forceinline__ float bfhi(unsigned w) { return __builtin_bit_cast(float, w & 0xffff0000u); }
__device__ __forceinline__ float wave_sum(float v) {
#pragma unroll
    for (int o = 1; o < 64; o <<= 1) v += __shfl_xor(v, o);
    return v;
}
#define MFMA16(a, b, c) __builtin_amdgcn_mfma_f32_16x16x32_bf16((a), (b), (c), 0, 0, 0)
__device__ __forceinline__ s16x4 tr_read(LAS const unsigned char* p) { return __builtin_bit_cast(s16x4, __builtin_amdgcn_ds_read_tr16_b64_v4i16((LAS v4i16_t*)p)); }
__device__ __forceinline__ bf16x8 cat4(s16x4 a, s16x4 b) { return __builtin_shufflevector(a, b, 0, 1, 2, 3, 4, 5, 6, 7); }
__device__ __forceinline__ bf16x8 pack_f8(const f32x4& a, const f32x4& b) { v4u w = pg8::pack8(a, b); return __builtin_bit_cast(bf16x8, w); }

__device__ __forceinline__ void transpose_item(const float* W, int K, int N, bf16* WT, int k0, int n0, int drow0, LAS float* scr, int lane) {
#pragma unroll 8
    for (int i = 0; i < 32; ++i) { const int kk = 2 * i + (lane >> 5); scr[kk * 33 + (lane & 31)] = W[(size_t)(k0 + kk) * N + n0 + (lane & 31)]; }
    asm volatile("s_waitcnt lgkmcnt(0)" ::: "memory");
    const int c = lane & 7;
#pragma unroll
    for (int j = 0; j < 4; ++j) { const int n = (lane >> 3) + 8 * j; const LAS float* s = scr + (8 * c) * 33 + n;
        v4u o; o.x = pk2(s[0 * 33], s[1 * 33]); o.y = pk2(s[2 * 33], s[3 * 33]); o.z = pk2(s[4 * 33], s[5 * 33]); o.w = pk2(s[6 * 33], s[7 * 33]);
        *(v4u*)(WT + (size_t)(drow0 + n) * K + k0 + 8 * c) = o; }
    asm volatile("s_waitcnt lgkmcnt(0)" ::: "memory");
}
__device__ __forceinline__ bool transpose_family(int& it, const float* W, int cnt, int K, int N, bf16* dst, size_t dstride, int mode, LAS float* scr, int lane) {
    const int nblk = N / 32, per = (K / 64) * nblk, tot = cnt * per;
    if (it >= tot) { it -= tot; return false; }
    const int mi = it / per, r = it % per, kb = r / nblk, nb = r % nblk, n0 = nb * 32; int drow = n0;
    if (mode == 1) { if (n0 < 2048) drow = 256 * ((n0 & 1023) >> 7) + 128 * (n0 >> 10) + (n0 & 127); }
    else if (mode == 2) { const int half = n0 >= DFF ? 1 : 0, jj = n0 - half * DFF; drow = 256 * (jj >> 7) + 128 * half + (jj & 127); }
    transpose_item(W + (size_t)mi * K * N, K, N, dst + (size_t)mi * dstride, kb * 64, n0, drow, scr, lane);
    return true;
}

__device__ __forceinline__ void row_phase(const float* hin, float* hout, const bf16* Y, const float* gate, const float* ngy,
                                          bf16* U, const float* ngu, const float* sc, const float* sh, int gw, int NGW, int lane) {
    for (int row = gw; row < M; row += NGW) {
        const int b = row >> 12; const size_t ro = (size_t)row * D;
        float hv[16];
#pragma unroll
        for (int j = 0; j < 2; ++j) { const f32x4 a = *(const f32x4*)(hin + ro + 8 * lane + 512 * j), c = *(const f32x4*)(hin + ro + 8 * lane + 512 * j + 4);
#pragma unroll
            for (int e = 0; e < 4; ++e) { hv[8 * j + e] = a[e]; hv[8 * j + 4 + e] = c[e]; } }
        if (Y) {
            float yv[16]; float ss = 0.f;
#pragma unroll
            for (int j = 0; j < 2; ++j) { const v4u w = *(const v4u*)(Y + ro + 8 * lane + 512 * j);
#pragma unroll
                for (int e = 0; e < 4; ++e) { yv[8 * j + 2 * e] = bflo(w[e]); yv[8 * j + 2 * e + 1] = bfhi(w[e]); } }
#pragma unroll
            for (int e = 0; e < 16; ++e) ss += yv[e] * yv[e];
            const float rstd = __builtin_amdgcn_rsqf(wave_sum(ss) * (1.0f / D) + EPS);
#pragma unroll
            for (int j = 0; j < 2; ++j) {
                const int col = 8 * lane + 512 * j;
#pragma unroll
                for (int q = 0; q < 2; ++q) { const f32x4 gt = *(const f32x4*)(gate + (size_t)b * 6144 + col + 4 * q), ng = *(const f32x4*)(ngy + col + 4 * q); f32x4 o;
#pragma unroll
                    for (int e = 0; e < 4; ++e) { hv[8 * j + 4 * q + e] += (1.0f + gt[e]) * (yv[8 * j + 4 * q + e] * rstd * ng[e]); o[e] = hv[8 * j + 4 * q + e]; }
                    *(f32x4*)(hout + ro + col + 4 * q) = o; }
            }
        }
        if (U) {
            float ss = 0.f;
#pragma unroll
            for (int e = 0; e < 16; ++e) ss += hv[e] * hv[e];
            const float rstd = __builtin_amdgcn_rsqf(wave_sum(ss) * (1.0f / D) + EPS);
#pragma unroll
            for (int j = 0; j < 2; ++j) {
                const int col = 8 * lane + 512 * j; float uv[8];
#pragma unroll
                for (int q = 0; q < 2; ++q) { const f32x4 ng = *(const f32x4*)(ngu + col + 4 * q), s1 = *(const f32x4*)(sc + (size_t)b * 6144 + col + 4 * q), s0 = *(const f32x4*)(sh + (size_t)b * 6144 + col + 4 * q);
#pragma unroll
                    for (int e = 0; e < 4; ++e) uv[4 * q + e] = hv[8 * j + 4 * q + e] * rstd * ng[e] * (1.0f + s1[e]) + s0[e]; }
                v4u w; w.x = pk2(uv[0], uv[1]); w.y = pk2(uv[2], uv[3]); w.z = pk2(uv[4], uv[5]); w.w = pk2(uv[6], uv[7]);
                *(v4u*)(U + ro + col) = w;
            }
        }
    }
}

__device__ __forceinline__ void hgrn_scan(LAS unsigned char* L, const bf16* QD, const bf16* KI, const bf16* VV, const bf16* GG, const float* DEC,
                                          const float* ngh, bf16* Uo, int tid, int wave, int lane) {
    if (blockIdx.x >= 64) return;
    constexpr int PITCH = 288, TB = 32 * PITCH, BUF = 28672, DOFF = 3 * TB, SSOFF = 2 * BUF;
    const int b = blockIdx.x >> 3, h = blockIdx.x & 7, fr = lane & 15, g = lane >> 4, q4 = fr >> 2, p4 = fr & 3;
    const size_t rowbase = (size_t)b * SEQ * D + h * HD;
    const int lrow = tid >> 4, lch = tid & 15;
    f32x4 S[8];
#pragma unroll
    for (int i = 0; i < 8; ++i) S[i] = (f32x4){0.f, 0.f, 0.f, 0.f};
    { const size_t src = rowbase + (size_t)lrow * D + lch * 8; LAS unsigned char* d = L + lrow * PITCH + lch * 16;
      *(LAS v4u*)(d) = *(const v4u*)(QD + src); *(LAS v4u*)(d + TB) = *(const v4u*)(KI + src); *(LAS v4u*)(d + 2 * TB) = *(const v4u*)(VV + src);
      if (tid < 32) *(LAS f32x4*)(L + DOFF + tid * 16) = *(const f32x4*)(DEC + (size_t)(b * 128) * D + h * HD + tid * 4); }
    __syncthreads();
    const f32x4 ngv = *(const f32x4*)(ngh + h * HD + 16 * wave + 4 * g);
#pragma unroll 1
    for (int c = 0; c < 128; ++c) {
        LAS unsigned char* B0 = L + (c & 1) * BUF; LAS unsigned char* B1 = L + ((c & 1) ^ 1) * BUF;
        const bool more = (c + 1) < 128;
        v4u pq = {0, 0, 0, 0}, pk = {0, 0, 0, 0}, pv = {0, 0, 0, 0}; f32x4 pd = {0.f, 0.f, 0.f, 0.f};
        if (more) { const size_t src = rowbase + (size_t)((c + 1) * 32 + lrow) * D + lch * 8; pq = *(const v4u*)(QD + src); pk = *(const v4u*)(KI + src); pv = *(const v4u*)(VV + src);
                    if (tid < 32) pd = *(const f32x4*)(DEC + (size_t)(b * 128 + c + 1) * D + h * HD + tid * 4); }
        v2u gt[2];
#pragma unroll
        for (int ct = 0; ct < 2; ++ct) gt[ct] = *(const v2u*)(GG + rowbase + (size_t)(c * 32 + 16 * ct + fr) * D + 16 * wave + 4 * g);
        bf16x8 qf[2][4];
#pragma unroll
        for (int ct = 0; ct < 2; ++ct)
#pragma unroll
            for (int ks = 0; ks < 4; ++ks) { LAS const unsigned char* p = B0 + (16 * ct + fr) * PITCH + (32 * ks + 4 * g) * 2; qf[ct][ks] = cat4(*(LAS const s16x4*)p, *(LAS const s16x4*)(p + 32)); }
        f32x4 o[2] = {(f32x4){0.f, 0.f, 0.f, 0.f}, (f32x4){0.f, 0.f, 0.f, 0.f}};
#pragma unroll
        for (int ks = 0; ks < 4; ++ks) { const bf16x8 sf = pack_f8(S[2 * ks], S[2 * ks + 1]); o[0] = MFMA16(sf, qf[0][ks], o[0]); o[1] = MFMA16(sf, qf[1][ks], o[1]); }
        f32x4 a00 = {0.f, 0.f, 0.f, 0.f}, a01 = {0.f, 0.f, 0.f, 0.f}, a11 = {0.f, 0.f, 0.f, 0.f};
#pragma unroll
        for (int ks = 0; ks < 4; ++ks) { LAS const unsigned char* p = B0 + TB + fr * PITCH + (32 * ks + 4 * g) * 2;
            const bf16x8 k0 = cat4(*(LAS const s16x4*)p, *(LAS const s16x4*)(p + 32)), k1 = cat4(*(LAS const s16x4*)(p + 16 * PITCH), *(LAS const s16x4*)(p + 16 * PITCH + 32));
            a00 = MFMA16(k0, qf[0][ks], a00); a01 = MFMA16(k0, qf[1][ks], a01); a11 = MFMA16(k1, qf[1][ks], a11); }
#pragma unroll
        for (int r = 0; r < 4; ++r) if (4 * g + r > fr) { a00[r] = 0.f; a11[r] = 0.f; }
        { const bf16x8 pf0 = pack_f8(a00, (f32x4){0.f, 0.f, 0.f, 0.f}), pf1 = pack_f8(a01, a11);
          LAS const unsigned char* p = B0 + 2 * TB + (4 * g + q4) * PITCH + (16 * wave + 4 * p4) * 2; const bf16x8 vf = cat4(tr_read(p), tr_read(p + 16 * PITCH));
          o[0] = MFMA16(vf, pf0, o[0]); o[1] = MFMA16(vf, pf1, o[1]); }
        { LAS const unsigned char* pvv = B0 + 2 * TB + (8 * g + q4) * PITCH + (16 * wave + 4 * p4) * 2; const bf16x8 vb = cat4(tr_read(pvv), tr_read(pvv + 4 * PITCH));
#pragma unroll
          for (int kt = 0; kt < 8; ++kt) { LAS const unsigned char* pkk = B0 + TB + (8 * g + q4) * PITCH + (16 * kt + 4 * p4) * 2; const bf16x8 kf = cat4(tr_read(pkk), tr_read(pkk + 4 * PITCH));
              S[kt] = MFMA16(kf, vb, S[kt]); const f32x4 dv = *(LAS const f32x4*)(B0 + DOFF + (16 * kt + 4 * g) * 4); S[kt] = S[kt] * dv; } }
#pragma unroll
        for (int ct = 0; ct < 2; ++ct) { float ss = o[ct][0] * o[ct][0] + o[ct][1] * o[ct][1] + o[ct][2] * o[ct][2] + o[ct][3] * o[ct][3]; ss += __shfl_xor(ss, 16); ss += __shfl_xor(ss, 32);
            if (g == 0) *(LAS float*)(L + SSOFF + ((c & 1) * 8 + wave) * 128 + (16 * ct + fr) * 4) = ss; }
        if (more) { LAS unsigned char* d = B1 + lrow * PITCH + lch * 16; *(LAS v4u*)(d) = pq; *(LAS v4u*)(d + TB) = pk; *(LAS v4u*)(d + 2 * TB) = pv; if (tid < 32) *(LAS f32x4*)(B1 + DOFF + tid * 16) = pd; }
        __syncthreads();
#pragma unroll
        for (int ct = 0; ct < 2; ++ct) { float tot = 0.f;
#pragma unroll
            for (int w2 = 0; w2 < 8; ++w2) tot += *(LAS const float*)(L + SSOFF + ((c & 1) * 8 + w2) * 128 + (16 * ct + fr) * 4);
            const float rstd = __builtin_amdgcn_rsqf(tot * (1.0f / HD) + EPS);
            f32x4 r; r[0] = o[ct][0] * rstd * ngv[0] * pg8::silu_f(bflo(gt[ct].x)); r[1] = o[ct][1] * rstd * ngv[1] * pg8::silu_f(bfhi(gt[ct].x));
            r[2] = o[ct][2] * rstd * ngv[2] * pg8::silu_f(bflo(gt[ct].y)); r[3] = o[ct][3] * rstd * ngv[3] * pg8::silu_f(bfhi(gt[ct].y));
            *(v2u*)(Uo + rowbase + (size_t)(c * 32 + 16 * ct + fr) * D + 16 * wave + 4 * g) = pg8::pack4(r); }
    }
}

template <int DIL>
__device__ __forceinline__ void attn_group(LAS unsigned char* L, const bf16* Q, const bf16* K, const bf16* V, bf16* ORUN, float* LSE, bool first, int tid, int wave, int lane) {
    constexpr int KP = 272, VP = 288, VOFF = 256 * KP, NB = 32 / DIL;
    const int fr = lane & 15, g = lane >> 4, q4 = fr >> 2, p4 = fr & 3;
    const float NEG = -__builtin_inff();
#pragma unroll 1
    for (int uu = 0; uu < 8; ++uu) {
        const int u = blockIdx.x * 8 + uu, bh = u >> 5, b = bh >> 3, h = bh & 7, rem = u & 31, r = rem / NB, n = rem % NB;
        __syncthreads();
#pragma unroll
        for (int pass = 0; pass < 8; ++pass) {
            const int kk = pass * 32 + (tid >> 4), ch = tid & 15, m = 128 * (n - 1) + kk;
            v4u kv = {0, 0, 0, 0}, vv = {0, 0, 0, 0};
            if (m >= 0) { const size_t src = (size_t)(b * SEQ + m * DIL + r) * D + h * HD + ch * 8; kv = *(const v4u*)(K + src); vv = *(const v4u*)(V + src); }
            *(LAS v4u*)(L + kk * KP + ch * 16) = kv; *(LAS v4u*)(L + VOFF + kk * VP + ch * 16) = vv;
        }
        const int qi = 16 * wave + fr; const size_t qrow = (size_t)(b * SEQ + (128 * n + qi) * DIL + r);
        bf16x8 qf[4];
#pragma unroll
        for (int ks = 0; ks < 4; ++ks) qf[ks] = *(const bf16x8*)(Q + qrow * D + h * HD + 32 * ks + 8 * g);
        __syncthreads();
        const int kt0 = (16 * wave < 96) ? 16 * wave : 96;
        f32x4 s[10];
#pragma unroll
        for (int t = 0; t < 10; ++t) { s[t] = (f32x4){0.f, 0.f, 0.f, 0.f};
#pragma unroll
            for (int ks = 0; ks < 4; ++ks) { const bf16x8 a = *(LAS const bf16x8*)(L + (kt0 + 16 * t + fr) * KP + ks * 64 + g * 16); s[t] = MFMA16(a, qf[ks], s[t]); } }
        float mx = NEG;
#pragma unroll
        for (int t = 0; t < 10; ++t)
#pragma unroll
            for (int rg = 0; rg < 4; ++rg) { const int ki = kt0 + 16 * t + 4 * g + rg; const bool ok = (ki >= qi) && (ki <= qi + 128) && (n > 0 || ki >= 128);
                s[t][rg] = ok ? s[t][rg] : NEG; mx = fmaxf(mx, s[t][rg]); }
        mx = fmaxf(mx, __shfl_xor(mx, 16)); mx = fmaxf(mx, __shfl_xor(mx, 32));
        float z = 0.f;
#pragma unroll
        for (int t = 0; t < 10; ++t)
#pragma unroll
            for (int rg = 0; rg < 4; ++rg) { const float p = __expf(s[t][rg] - mx); s[t][rg] = p; z += p; }
        z += __shfl_xor(z, 16); z += __shfl_xor(z, 32);
        f32x4 o[8];
#pragma unroll
        for (int dt = 0; dt < 8; ++dt) o[dt] = (f32x4){0.f, 0.f, 0.f, 0.f};
#pragma unroll
        for (int j = 0; j < 5; ++j) { const bf16x8 pf = pack_f8(s[2 * j], s[2 * j + 1]);
#pragma unroll
            for (int dt = 0; dt < 8; ++dt) { LAS const unsigned char* p = L + VOFF + (kt0 + 32 * j + 4 * g + q4) * VP + (16 * dt + 4 * p4) * 2;
                const bf16x8 vf = cat4(tr_read(p), tr_read(p + 16 * VP)); o[dt] = MFMA16(vf, pf, o[dt]); } }
        float lse = mx + __logf(z), w_new = 1.0f / z, w_old = 0.f;
        if (!first) { const float lo = LSE[qrow * 8 + h], mm = fmaxf(lo, lse), e1 = __expf(lo - mm), e2 = __expf(lse - mm), den = e1 + e2;
            w_old = e1 / den; w_new = w_new * e2 / den; lse = mm + __logf(den); }
        bf16* op = ORUN + qrow * D + h * HD + 4 * g;
#pragma unroll
        for (int dt = 0; dt < 8; ++dt) { f32x4 rr = o[dt] * w_new;
            if (!first) { const v2u pr = *(const v2u*)(op + 16 * dt); rr[0] += w_old * bflo(pr.x); rr[1] += w_old * bfhi(pr.x); rr[2] += w_old * bflo(pr.y); rr[3] += w_old * bfhi(pr.y); }
            *(v2u*)(op + 16 * dt) = pg8::pack4(rr); }
        if (g == 0) LSE[qrow * 8 + h] = lse;
    }
}
#ifndef SKIP_HG
#define SKIP_HG 0
#endif
#ifndef SKIP_SCAN
#define SKIP_SCAN 0
#endif
#ifndef SKIP_ROPE
#define SKIP_ROPE 0
#endif
#ifndef SKIP_ATT
#define SKIP_ATT 0
#endif
#ifndef SKIP_SWI
#define SKIP_SWI 0
#endif
#ifndef SKIP_PLAIN
#define SKIP_PLAIN 0
#endif
#ifndef SKIP_P0
#define SKIP_P0 0
#endif

struct Args { const void* in[14]; float* out; unsigned char* ws; };
#define GEMM_PHASE(EpiT, Eobj, Aptr, Bptr, N_, K_) do { pg8::Gemm g_{(const pg8::bf16_t*)(Aptr), (const pg8::bf16_t*)(Bptr), M, (N_), (K_)}; pg8::StaticOrder S_; S_.init(M, (N_), G, (int)blockIdx.x); \
    pg8::gemm_phase<EpiT, pg8::StaticOrder, true, true>(L, g_, S_, Eobj); } while (0)

__global__ void __launch_bounds__(NWAVES * 64, 2) fwd_kernel(Args a) {
    extern __shared__ __attribute__((aligned(16))) unsigned char lds_raw[];
    cg::grid_group grid = cg::this_grid();
    LAS unsigned char* L = (LAS unsigned char*)lds_raw;
    const int G = gridDim.x, NGW = G * NWAVES;
#define FRESH_IDS int tid = threadIdx.x; asm volatile("" : "+v"(tid)); const int lane = tid & 63, wave = __builtin_amdgcn_readfirstlane(tid >> 6), gw = blockIdx.x * NWAVES + wave; (void)lane; (void)wave; (void)gw;
    unsigned char* ws = a.ws;
    const float* x = (const float*)a.in[0]; const float* cin = (const float*)a.in[1]; const int* pos = (const int*)a.in[2];
    const float* ada_w = (const float*)a.in[3]; const float* ada_b = (const float*)a.in[4]; const float* norm_g = (const float*)a.in[5];
    const float* lbraw = (const float*)a.in[7]; const float* hgrn_ng = (const float*)a.in[8];
    float* out = a.out;
    float* MOD = (float*)(ws + WS_MOD); float* LB = (float*)(ws + WS_LB); float* CS = (float*)(ws + WS_ROPE); float* SN = CS + (size_t)M * 16; float* LSE = (float*)(ws + WS_LSE);
    bf16* U = (bf16*)(ws + WS_U); unsigned char* R = ws + WS_R;
    bf16* const T0 = (bf16*)R; bf16* const T1 = (bf16*)(R + 64 * MiB); bf16* const T2 = (bf16*)(R + 128 * MiB); bf16* const T3 = (bf16*)(R + 192 * MiB); float* const DEC = (float*)(R + 256 * MiB);

    if (!SKIP_P0) { FRESH_IDS
        LAS float* condL = (LAS float*)L; LAS float* part = (LAS float*)(L + 32768);
        for (int i = tid; i < BATCH * D; i += NWAVES * 64) { const float v = cin[i]; condL[i] = v / (1.0f + expf(-v)); }
        __syncthreads();
        for (int item = blockIdx.x; item < 4 * 96; item += G) {
            const int l = item / 96, cc = item % 96, col = cc * 64 + lane;
            const float* wp = ada_w + ((size_t)l * D + wave * 128) * 6144 + col;
            float acc[8];
#pragma unroll
            for (int bb = 0; bb < 8; ++bb) acc[bb] = 0.f;
#pragma unroll 8
            for (int k = 0; k < 128; ++k) { const float w = wp[(size_t)k * 6144];
#pragma unroll
                for (int bb = 0; bb < 8; ++bb) acc[bb] += condL[bb * D + wave * 128 + k] * w; }
#pragma unroll
            for (int bb = 0; bb < 8; ++bb) part[(wave * 8 + bb) * 64 + lane] = acc[bb];
            __syncthreads();
            { const int bb = tid >> 6; float s = 0.f;
#pragma unroll
              for (int w2 = 0; w2 < 8; ++w2) s += part[(w2 * 8 + bb) * 64 + lane];
              MOD[(size_t)(l * 8 + bb) * 6144 + cc * 64 + lane] = s + ada_b[l * 6144 + cc * 64 + lane]; }
            __syncthreads();
        }
        if (blockIdx.x == 0) for (int i = tid; i < D; i += NWAVES * 64) { LB[i] = 0.f; LB[D + i] = 1.0f / (1.0f + expf(-(lbraw[D + i] - lbraw[i]))); }
        for (int i = blockIdx.x * (NWAVES * 64) + tid; i < M * 16; i += G * NWAVES * 64) {
            const int m = i >> 4, f = i & 15; const float invf = (float)pow(500000.0, -(double)f / 16.0); const float ang = (float)pos[m] * invf;
            CS[i] = cosf(ang); SN[i] = sinf(ang); }
        __syncthreads();
        LAS float* scr = (LAS float*)(L + wave * 16384);
        for (int it0 = gw; it0 < 32256; it0 += NGW) { int it = it0;
            if (transpose_family(it, (const float*)a.in[6], 2, D, 4 * D, (bf16*)(ws + W_HIN), (size_t)4 * D * D, 1, scr, lane)) continue;
            if (transpose_family(it, (const float*)a.in[9], 2, D, D, (bf16*)(ws + W_HOUT), (size_t)D * D, 0, scr, lane)) continue;
            if (transpose_family(it, (const float*)a.in[10], 2, D, 9 * D, (bf16*)(ws + W_AIN), (size_t)9 * D * D, 0, scr, lane)) continue;
            if (transpose_family(it, (const float*)a.in[11], 2, D, D, (bf16*)(ws + W_AOUT), (size_t)D * D, 0, scr, lane)) continue;
            if (transpose_family(it, (const float*)a.in[12], 4, D, 2 * DFF, (bf16*)(ws + W_FIN), (size_t)2 * DFF * D, 2, scr, lane)) continue;
            transpose_family(it, (const float*)a.in[13], 4, DFF, D, (bf16*)(ws + W_FOUT), (size_t)DFF * D, 0, scr, lane);
        }
    }
    grid.sync();
    { FRESH_IDS row_phase(x, nullptr, nullptr, nullptr, nullptr, U, norm_g, MOD + 1024, MOD, gw, NGW, lane); }
    grid.sync();

#pragma unroll 1
    for (int l = 0; l < DEPTH; ++l) {
        const float* modl = MOD + (size_t)l * 8 * 6144; const float* ngl = norm_g + (size_t)l * 4 * D; const int idx = l >> 1;
#pragma unroll 1
        for (int half = 0; half < 2; ++half) {
            const bf16* Ain; const bf16* Bout; int Kout; bf16* Yp;
            if (half == 0) {
                if ((l & 1) == 0) {
                    if (!SKIP_HG) { pg8::EpiHgrn E{T0, T1, T2, T3, DEC, LB + idx * D}; GEMM_PHASE(pg8::EpiHgrn, E, U, (bf16*)(ws + W_HIN) + (size_t)idx * 4 * D * D, 4 * D, D); }
                    grid.sync();
                    if (!SKIP_SCAN) { FRESH_IDS hgrn_scan(L, T0, T1, T2, T3, DEC, hgrn_ng + idx * D, U, tid, wave, lane); }
                    Ain = U; Bout = (bf16*)(ws + W_HOUT) + (size_t)idx * D * D;
                } else {
#pragma unroll 1
                    for (int gi = 0; gi < 3; ++gi) {
                        if (!SKIP_ROPE) { pg8::EpiRope E{T0, (size_t)M * D, CS, SN}; GEMM_PHASE(pg8::EpiRope, E, U, (bf16*)(ws + W_AIN) + (size_t)idx * 9 * D * D + (size_t)gi * 3 * D * D, 3 * D, D); }
                        grid.sync();
                        { FRESH_IDS if (SKIP_ATT) {} else if (gi == 0) attn_group<1>(L, T0, T1, T2, T3, LSE, true, tid, wave, lane);
                        else if (gi == 1) attn_group<4>(L, T0, T1, T2, T3, LSE, false, tid, wave, lane);
                        else attn_group<16>(L, T0, T1, T2, T3, LSE, false, tid, wave, lane); }
                        if (gi < 2) grid.sync();
                    }
                    Ain = T3; Bout = (bf16*)(ws + W_AOUT) + (size_t)idx * D * D;
                }
                Kout = D; Yp = T0;
            } else {
                if (!SKIP_SWI) { pg8::EpiSwiglu E{T0, DFF}; GEMM_PHASE(pg8::EpiSwiglu, E, U, (bf16*)(ws + W_FIN) + (size_t)l * 2 * DFF * D, 2 * DFF, D); }
                Ain = T0; Bout = (bf16*)(ws + W_FOUT) + (size_t)l * DFF * D; Kout = DFF; Yp = T3;
            }
            grid.sync();
            if (!SKIP_PLAIN) { pg8::EpiPlain E{Yp, D}; GEMM_PHASE(pg8::EpiPlain, E, Ain, Bout, D, Kout); }
            grid.sync();
            { FRESH_IDS if (half == 0) row_phase((l == 0) ? x : out, out, Yp, modl + 2 * 1024, ngl + D, U, ngl + 2 * D, modl + 4 * 1024, modl + 3 * 1024, gw, NGW, lane);
            else row_phase(out, out, Yp, modl + 5 * 1024, ngl + 3 * D, (l < DEPTH - 1) ? U : nullptr, ngl + 4 * D, modl + 8 * 6144 + 1024, modl + 8 * 6144, gw, NGW, lane); }
            if (!(l == DEPTH - 1 && half == 1)) grid.sync();
        }
    }
}

extern "C" void kernel_launch(void* const* d_in, const int* in_sizes, int n_in, void* d_out, int out_size, void* d_ws, size_t ws_size, hipStream_t stream) {
    static int grid = 0;
    if (grid == 0) {
        if (n_in != 14 || out_size != M * D || ws_size < WS_END) { fprintf(stderr, "kernel_launch: unexpected shapes (n_in %d out %d ws %zu)\n", n_in, out_size, ws_size); grid = -1; return; }
        int dev = 0, cus = 0, per_cu = 0;
        if (hipGetDevice(&dev) != hipSuccess || hipDeviceGetAttribute(&cus, hipDeviceAttributeMultiprocessorCount, dev) != hipSuccess) { grid = -1; return; }
        if (hipFuncSetAttribute((const void*)fwd_kernel, hipFuncAttributeMaxDynamicSharedMemorySize, LDS_BYTES) != hipSuccess) { fprintf(stderr, "kernel_launch: hipFuncSetAttribute failed\n"); grid = -1; return; }
        if (hipOccupancyMaxActiveBlocksPerMultiprocessor(&per_cu, (const void*)fwd_kernel, NWAVES * 64, LDS_BYTES) != hipSuccess || per_cu < 1) { fprintf(stderr, "kernel_launch: occupancy query says %d\n", per_cu); (void)hipGetLastError(); per_cu = 1; }
        grid = cus;
        if (grid != 256) { fprintf(stderr, "kernel_launch: built for 256 CUs, device has %d\n", cus); grid = -1; return; }
    }
    if (grid < 0) return;
    Args a{};
    for (int i = 0; i < 14; ++i) a.in[i] = d_in[i];
    a.out = (float*)d_out; a.ws = (unsigned char*)d_ws;
    void* args[] = {&a};
    hipError_t e = hipLaunchCooperativeKernel((const void*)fwd_kernel, dim3(grid), dim3(NWAVES * 64), args, LDS_BYTES, stream);
    if (e != hipSuccess) fprintf(stderr, "kernel_launch: cooperative launch failed: %s\n", hipGetErrorString(e));
}
```

```cpp
#include <hip/hip_runtime.h>
#include <hip/hip_cooperative_groups.h>
#include <cstdio>
#include <cstdint>
namespace cg = cooperative_groups;
namespace pg8 {
#define PG8_LAS __attribute__((address_space(3)))
typedef unsigned short bf16_t;
typedef short bf16x8 __attribute__((ext_vector_type(8)));
typedef float f32x4 __attribute__((ext_vector_type(4)));
typedef unsigned u32x4 __attribute__((ext_vector_type(4)));
constexpr int BM = 256, BK = 64, HALF = 128, HTB = HALF * BK * 2  , STAGE_BYTES = 8 * HTB, NXCD = 8, WGM = 8;

__host__ __device__ __forceinline__ int lds_byte(int r, int c) { const int st = (r >> 4) * 2 + (c >> 5), rr = r & 15, cc = c & 31, ob = rr * 64 + cc * 2; return st * 1024 + (ob ^ (((ob >> 9) & 1) << 5)); }
__host__ __device__ __forceinline__ void stage_rc(int b, int& R, int& C) { const int st = b / 1024, sb = b % 1024, swz = sb ^ (((sb >> 9) & 1) << 5); R = (st >> 1) * 16 + swz / 64; C = (st & 1) * 32 + (swz % 64) / 2; }
__host__ __device__ __forceinline__ int perm32(int rho) { const int n = rho >> 4, i = rho & 15; return 8 * (i >> 2) + 4 * n + (i & 3); }

struct Unit { int pm, pn; };
struct Gemm { const bf16_t* A; const bf16_t* Bt; int M, N, K; };

struct StaticOrder {
    int nM, nN, nwg, G, c;
    __host__ __device__ void init(int M, int N, int G_, int c_) { nM = M / BM; nN = N / BM; nwg = nM * nN; G = G_; c = c_; }
    __host__ __device__ bool next(int i, Unit& u) const {
        const long L = (long)i * G + c; if (L >= nwg) return false;
        int wgid = (int)L; { const int q = nwg / NXCD, r = nwg % NXCD, xcd = wgid % NXCD, off = wgid / NXCD; wgid = (xcd < r ? xcd * (q + 1) : r * (q + 1) + (xcd - r) * q) + off; }
        const int nig = WGM * nN, gid = wgid / nig, fm = gid * WGM, gsz = (nM - fm) < WGM ? (nM - fm) : WGM;
        u.pm = fm + ((wgid % nig) % gsz); u.pn = (wgid % nig) / gsz; return true;
    }
    __device__ __forceinline__ void a_ready(const Unit&) const {}
    __device__ __forceinline__ void done(const Unit&) const {}
};

#define PG8_GAS __attribute__((address_space(1)))
typedef float f32x2 __attribute__((ext_vector_type(2)));
typedef __bf16 bf16x2_t __attribute__((ext_vector_type(2)));
typedef unsigned u32x2 __attribute__((ext_vector_type(2)));
__device__ __forceinline__ unsigned cvt_pk_bf16(float lo, float hi) { unsigned r; asm volatile("v_cvt_pk_bf16_f32 %0, %1, %2" : "=v"(r) : "v"(lo), "v"(hi)); return r; }
__device__ __forceinline__ unsigned cvt_pk_bf16_c(float lo, float hi) { f32x2 v = {lo, hi}; bf16x2_t b = __builtin_convertvector(v, bf16x2_t); return __builtin_bit_cast(unsigned, b); }
__device__ __forceinline__ float silu_f(float x) { return x * __builtin_amdgcn_rcpf(1.0f + __expf(-x)); }
__device__ __forceinline__ u32x4 pack8(const f32x4& a, const f32x4& b) { u32x4 w; w.x = cvt_pk_bf16(a[0], a[1]); w.y = cvt_pk_bf16(a[2], a[3]); w.z = cvt_pk_bf16(b[0], b[1]); w.w = cvt_pk_bf16(b[2], b[3]); return w; }
__device__ __forceinline__ u32x2 pack4(const f32x4& a) { u32x2 w; w.x = cvt_pk_bf16(a[0], a[1]); w.y = cvt_pk_bf16(a[2], a[3]); return w; }
__device__ __forceinline__ u32x4 pack8_c(const f32x4& a, const f32x4& b) { u32x4 w; w.x = cvt_pk_bf16_c(a[0], a[1]); w.y = cvt_pk_bf16_c(a[2], a[3]); w.z = cvt_pk_bf16_c(b[0], b[1]); w.w = cvt_pk_bf16_c(b[2], b[3]); return w; }
__device__ __forceinline__ u32x2 pack4_c(const f32x4& a) { u32x2 w; w.x = cvt_pk_bf16_c(a[0], a[1]); w.y = cvt_pk_bf16_c(a[2], a[3]); return w; }

struct EpiPlain {
    static constexpr bool PERM = true, AFTER_DRAIN = false;
    bf16_t* O; int ldc;
    __device__ __forceinline__ void operator()(const f32x4 (&acc)[2][2][4][2], const Unit& u, int wr, int wc, int fr, int fq) const {
        const int row0 = u.pm * BM + wr * 64 + fr, col0 = u.pn * BM + wc * 32 + 8 * fq;
#pragma unroll
        for (int ai = 0; ai < 2; ++ai)
#pragma unroll
            for (int m = 0; m < 4; ++m) { bf16_t* rowp = O + (size_t)(row0 + ai * HALF + m * 16) * ldc + col0;
#pragma unroll
                for (int bj = 0; bj < 2; ++bj) *(PG8_GAS u32x4*)(rowp + bj * HALF) = pack8(acc[ai][bj][m][0], acc[ai][bj][m][1]); }
    }
};
struct EpiSwiglu {
    static constexpr bool PERM = true, AFTER_DRAIN = false;
    bf16_t* H; int ldc;
    __device__ __forceinline__ void operator()(const f32x4 (&acc)[2][2][4][2], const Unit& u, int wr, int wc, int fr, int fq) const {
        const int row0 = u.pm * BM + wr * 64 + fr, col0 = u.pn * HALF + wc * 32 + 8 * fq;
#pragma unroll
        for (int ai = 0; ai < 2; ++ai)
#pragma unroll
            for (int m = 0; m < 4; ++m) { f32x4 r0, r1;
#pragma unroll
                for (int i = 0; i < 4; ++i) { r0[i] = silu_f(acc[ai][0][m][0][i]) * acc[ai][1][m][0][i]; r1[i] = silu_f(acc[ai][0][m][1][i]) * acc[ai][1][m][1][i]; }
                *(PG8_GAS u32x4*)(H + (size_t)(row0 + ai * HALF + m * 16) * ldc + col0) = pack8(r0, r1); }
    }
};
struct EpiRope {
    static constexpr bool PERM = true, AFTER_DRAIN = false;
    bf16_t* QKV; size_t tstride; const float* cs; const float* sn;
    __device__ __forceinline__ void operator()(const f32x4 (&acc)[2][2][4][2], const Unit& u, int wr, int wc, int fr, int fq) const {
        const int t = u.pn >> 2; bf16_t* base = QKV + (size_t)t * tstride;
        const int row0 = u.pm * BM + wr * 64 + fr, col0 = (u.pn & 3) * BM + wc * 32 + 8 * fq;
        const bool rope = (t < 2) && (wc == 0); const float scale = (t == 0) ? 0.08838834764831845f : 1.0f;
        const float sgn = (fq < 2) ? -1.0f : 1.0f;
#pragma unroll
        for (int ai = 0; ai < 2; ++ai)
#pragma unroll
            for (int m = 0; m < 4; ++m) { const int row = row0 + ai * HALF + m * 16;
                f32x4 c0 = {1.f, 1.f, 1.f, 1.f}, c1 = c0, s0 = {0.f, 0.f, 0.f, 0.f}, s1 = s0;
                if (rope) { const float* cp = cs + (size_t)row * 16 + 8 * (fq & 1); const float* sp = sn + (size_t)row * 16 + 8 * (fq & 1);
                    c0 = *(const PG8_GAS f32x4*)cp; c1 = *(const PG8_GAS f32x4*)(cp + 4); s0 = *(const PG8_GAS f32x4*)sp * sgn; s1 = *(const PG8_GAS f32x4*)(sp + 4) * sgn; }
#pragma unroll
                for (int bj = 0; bj < 2; ++bj) { f32x4 v0 = acc[ai][bj][m][0], v1 = acc[ai][bj][m][1];
                    if (rope) { f32x4 p0, p1;
#pragma unroll
                        for (int i = 0; i < 4; ++i) { p0[i] = __shfl_xor(v0[i], 32); p1[i] = __shfl_xor(v1[i], 32); }
                        v0 = v0 * c0 + p0 * s0; v1 = v1 * c1 + p1 * s1; }
                    v0 = v0 * scale; v1 = v1 * scale;
                    *(PG8_GAS u32x4*)(base + (size_t)row * 1024 + col0 + bj * HALF) = pack8(v0, v1); } }
    }
};
#define DPP_SHR(x, n) __builtin_bit_cast(float, __builtin_amdgcn_update_dpp(0, __builtin_bit_cast(int, (x)), 0x110 + (n), 0xf, 0xf, false))
__device__ __forceinline__ float row_scan16(float x) { x += DPP_SHR(x, 1); x += DPP_SHR(x, 2); x += DPP_SHR(x, 4); x += DPP_SHR(x, 8); return x; }
#define DPP_SHR1(x, n) __builtin_bit_cast(float, __builtin_amdgcn_update_dpp(0x3f800000, __builtin_bit_cast(int, (x)), 0x110 + (n), 0xf, 0xf, false))
__device__ __forceinline__ float row_scanmul16(float x) { x *= DPP_SHR1(x, 1); x *= DPP_SHR1(x, 2); x *= DPP_SHR1(x, 4); x *= DPP_SHR1(x, 8); return x; }
struct EpiHgrn {
    static constexpr bool PERM = true, AFTER_DRAIN = false;
    bf16_t *QD, *KI, *VV, *GG; float* DEC; const float* lb;
    __device__ __forceinline__ void operator()(const f32x4 (&acc)[2][2][4][2], const Unit& u, int wr, int wc, int fr, int fq) const {
        const int row0 = u.pm * BM + wr * 64 + fr;
        if (u.pn >= 8) {
            bf16_t* base = (u.pn >= 12) ? GG : VV; const int col0 = (u.pn & 3) * BM + wc * 32 + 8 * fq;
#pragma unroll
            for (int ai = 0; ai < 2; ++ai)
#pragma unroll
                for (int m = 0; m < 4; ++m) { bf16_t* rowp = base + (size_t)(row0 + ai * HALF + m * 16) * 1024 + col0;
#pragma unroll
                    for (int bj = 0; bj < 2; ++bj) { f32x4 v0 = acc[ai][bj][m][0], v1 = acc[ai][bj][m][1];
                        if (u.pn >= 12) {
#pragma unroll
                            for (int i = 0; i < 4; ++i) { v0[i] = silu_f(v0[i]); v1[i] = silu_f(v1[i]); } }
                        *(PG8_GAS u32x4*)(rowp + bj * HALF) = pack8(v0, v1); } }
            return;
        }
        const int col0 = u.pn * HALF + wc * 32 + 8 * fq;
        const f32x4 lb0 = *(const PG8_GAS f32x4*)(lb + col0), lb1 = *(const PG8_GAS f32x4*)(lb + col0 + 4);
        const int lane15 = (threadIdx.x & 48) | 15;
#pragma unroll
        for (int ai = 0; ai < 2; ++ai)
#pragma unroll
            for (int mp = 0; mp < 2; ++mp) {
                const int ra = row0 + ai * HALF + mp * 32, rb = ra + 16;
                f32x4 qa[2], qb[2], ka[2], kb[2], dc[2];
#pragma unroll
                for (int n = 0; n < 2; ++n)
#pragma unroll
                    for (int i = 0; i < 4; ++i) {
                        const float lbv = n ? lb1[i] : lb0[i], oml = 1.0f - lbv;
                        const float fa = acc[ai][1][2 * mp][n][i], fb = acc[ai][1][2 * mp + 1][n][i];
                        const float ta = __expf(-fabsf(fa)), ra_ = __builtin_amdgcn_rcpf(1.0f + ta), sa = fa >= 0.f ? ra_ : ta * ra_, na = fa >= 0.f ? ta * ra_ : ra_;
                        const float tb = __expf(-fabsf(fb)), rb_ = __builtin_amdgcn_rcpf(1.0f + tb), sb = fb >= 0.f ? rb_ : tb * rb_, nb = fb >= 0.f ? tb * rb_ : rb_;
                        const float ca = row_scanmul16(lbv + oml * sa), cb0 = row_scanmul16(lbv + oml * sb);
                        const float tota = __shfl(ca, lane15), totb = __shfl(cb0, lane15);
                        const float pa = ca, pb = tota * cb0;
                        qa[n][i] = silu_f(acc[ai][0][2 * mp][n][i]) * pa; qb[n][i] = silu_f(acc[ai][0][2 * mp + 1][n][i]) * pb;
                        ka[n][i] = oml * na * __builtin_amdgcn_rcpf(pa); kb[n][i] = oml * nb * __builtin_amdgcn_rcpf(pb); dc[n][i] = tota * totb;
                    }
                *(PG8_GAS u32x4*)(QD + (size_t)ra * 1024 + col0) = pack8(qa[0], qa[1]); *(PG8_GAS u32x4*)(QD + (size_t)rb * 1024 + col0) = pack8(qb[0], qb[1]);
                *(PG8_GAS u32x4*)(KI + (size_t)ra * 1024 + col0) = pack8(ka[0], ka[1]); *(PG8_GAS u32x4*)(KI + (size_t)rb * 1024 + col0) = pack8(kb[0], kb[1]);
                if (fr == 0) { float* dp = DEC + (size_t)(ra >> 5) * 1024 + col0; *(PG8_GAS f32x4*)dp = dc[0]; *(PG8_GAS f32x4*)(dp + 4) = dc[1]; }
            }
    }
};

template <class Epi, class Sched, bool ALIGN_EPI = false, bool SP2 = false>
__device__ __forceinline__ void gemm_phase(PG8_LAS unsigned char* lds, const Gemm g, const Sched& S, const Epi& E) {
    int tid_o = threadIdx.x; asm volatile("" : "+v"(tid_o)); const int tid = tid_o, wid = __builtin_amdgcn_readfirstlane(tid >> 6), lane = tid & 63, wr = wid >> 2, wc = wid & 3, fr = lane & 15, fq = lane >> 4;
    const int K = g.K, nt = K / BK;
    unsigned voffA[2], voffB[2];
#pragma unroll
    for (int i = 0; i < 2; ++i) { int R, C; stage_rc(tid * 16 + i * 8192, R, C); const int Rb = Epi::PERM ? ((R & ~31) + perm32(R & 31)) : R;
        voffA[i] = (unsigned)(R * K + C) * 2u; voffB[i] = (unsigned)(Rb * K + C) * 2u; }
    const size_t kstep = (size_t)(BK * 2);
    const size_t hstep = (size_t)HALF * K * 2;
    const size_t tstep = 2 * hstep;
    const unsigned ldsw = (unsigned)wid * 1024u;
    const int aoff = lds_byte(wr * 64 + fr, fq * 8), boff = lds_byte(wc * 32 + fr, fq * 8);
#define PG8_SA(b, h) (((b) * 2 + (h)) * HTB)
#define PG8_SB(b, h) ((4 + (b) * 2 + (h)) * HTB)
#define PG8_STAGE(bufoff, gbase, voff) do { _Pragma("unroll") for (int _i = 0; _i < 2; ++_i) \
        __builtin_amdgcn_global_load_lds((const unsigned*)((const char*)(gbase) + (voff)[_i]), (PG8_LAS unsigned*)(lds + (bufoff) + ldsw + _i * 8192), 16, 0, 0); } while (0)
#define PG8_LDA(dst, b, h) do { _Pragma("unroll") for (int m = 0; m < 4; ++m) _Pragma("unroll") for (int k = 0; k < 2; ++k) dst[m][k] = *(const PG8_LAS bf16x8*)(lds + PG8_SA(b, h) + aoff + m * 2048 + k * 1024); } while (0)
#define PG8_LDB(dst, b, h) do { _Pragma("unroll") for (int n = 0; n < 2; ++n) _Pragma("unroll") for (int k = 0; k < 2; ++k) dst[n][k] = *(const PG8_LAS bf16x8*)(lds + PG8_SB(b, h) + boff + n * 2048 + k * 1024); } while (0)
#define PG8_MMA(ai, bj, At, Bt) do { __builtin_amdgcn_s_setprio(1); _Pragma("unroll") for (int m = 0; m < 4; ++m) _Pragma("unroll") for (int n = 0; n < 2; ++n) _Pragma("unroll") for (int k = 0; k < 2; ++k) \
        acc[ai][bj][m][n] = __builtin_amdgcn_mfma_f32_16x16x32_bf16(Bt[n][k], At[m][k], acc[ai][bj][m][n], 0, 0, 0); __builtin_amdgcn_s_setprio(0); } while (0)
#define PG8_WAIT_V(n) asm volatile("s_waitcnt vmcnt(" #n ")" ::: "memory")
#define PG8_WAIT_L(n) asm volatile("s_waitcnt lgkmcnt(" #n ")" ::: "memory")
#define PG8_BAR __builtin_amdgcn_s_barrier()
#define PG8_SCHED __builtin_amdgcn_sched_barrier(0)
    Unit cur, nxt; int ui = 0;
    if (!S.next(0, cur)) return;
    f32x4 acc[2][2][4][2];
#pragma unroll
    for (int a = 0; a < 2; ++a)
#pragma unroll
        for (int b = 0; b < 2; ++b)
#pragma unroll
            for (int m = 0; m < 4; ++m)
#pragma unroll
                for (int n = 0; n < 2; ++n) acc[a][b][m][n] = (f32x4){0.f, 0.f, 0.f, 0.f};
    bf16x8 At[4][2], B0[2][2], B1[2][2];
    const char* cA = (const char*)g.A + (size_t)cur.pm * tstep; const char* cB = (const char*)g.Bt + (size_t)cur.pn * tstep;
    S.a_ready(cur);
    if constexpr (SP2) {
        PG8_STAGE(PG8_SB(0, 0), cB, voffB); PG8_STAGE(PG8_SB(0, 1), cB + hstep, voffB); PG8_STAGE(PG8_SA(0, 0), cA, voffA); PG8_STAGE(PG8_SA(0, 1), cA + hstep, voffA);
        if (wr == 1) PG8_BAR;
        PG8_WAIT_V(2); PG8_BAR;
        PG8_STAGE(PG8_SB(1, 0), cB + kstep, voffB); PG8_STAGE(PG8_SA(1, 0), cA + kstep, voffA); PG8_STAGE(PG8_SB(1, 1), cB + hstep + kstep, voffB);
        PG8_WAIT_V(6); PG8_BAR;
    } else {
        PG8_STAGE(PG8_SB(0, 0), cB, voffB); PG8_STAGE(PG8_SA(0, 0), cA, voffA); PG8_STAGE(PG8_SB(0, 1), cB + hstep, voffB); PG8_STAGE(PG8_SA(0, 1), cA + hstep, voffA);
        if (wr == 1) PG8_BAR;
        PG8_WAIT_V(4); PG8_BAR;
        PG8_STAGE(PG8_SB(1, 0), cB + kstep, voffB); PG8_STAGE(PG8_SA(1, 0), cA + kstep, voffA); PG8_STAGE(PG8_SB(1, 1), cB + hstep + kstep, voffB);
        PG8_WAIT_V(6); PG8_BAR;
    }
    for (;;) {
        const bool has_next = S.next(ui + 1, nxt);
        const char* nA = has_next ? (const char*)g.A + (size_t)nxt.pm * tstep : cA; const char* nB = has_next ? (const char*)g.Bt + (size_t)nxt.pn * tstep : cB;
        for (int t = 0; t < nt; t += 2) {
            const bool last = (t == nt - 2);
            const char* a1 = cA + (size_t)(t + 1) * kstep;
            const char* a2 = last ? nA : cA + (size_t)(t + 2) * kstep; const char* b2 = last ? nB : cB + (size_t)(t + 2) * kstep;
            const char* a3 = a2 + kstep; const char* b3 = b2 + kstep;
            if (last && has_next) S.a_ready(nxt);
            if constexpr (SP2) {
            PG8_LDB(B0, 0, 0); PG8_LDB(B1, 0, 1); PG8_SCHED; PG8_LDA(At, 0, 0); PG8_STAGE(PG8_SA(1, 1), a1 + hstep, voffA);
            PG8_WAIT_V(8); PG8_WAIT_L(0); PG8_BAR; PG8_MMA(0, 0, At, B0); PG8_MMA(0, 1, At, B1); PG8_BAR; PG8_SCHED;
            PG8_LDA(At, 0, 1); PG8_STAGE(PG8_SB(0, 0), b2, voffB); PG8_STAGE(PG8_SB(0, 1), b2 + hstep, voffB); PG8_STAGE(PG8_SA(0, 0), a2, voffA);
            PG8_WAIT_V(8); PG8_WAIT_L(0); PG8_BAR; PG8_MMA(1, 0, At, B0); PG8_MMA(1, 1, At, B1); PG8_BAR; PG8_SCHED;
            PG8_LDB(B0, 1, 0); PG8_LDB(B1, 1, 1); PG8_SCHED; PG8_LDA(At, 1, 0); PG8_STAGE(PG8_SA(0, 1), a2 + hstep, voffA);
            PG8_WAIT_V(8); PG8_WAIT_L(0); PG8_BAR; PG8_MMA(0, 0, At, B0); PG8_MMA(0, 1, At, B1); PG8_BAR; PG8_SCHED;
            PG8_LDA(At, 1, 1); PG8_STAGE(PG8_SB(1, 0), b3, voffB); PG8_STAGE(PG8_SB(1, 1), b3 + hstep, voffB); PG8_STAGE(PG8_SA(1, 0), a3, voffA);
            PG8_WAIT_V(8); PG8_WAIT_L(0); PG8_BAR; PG8_MMA(1, 0, At, B0); PG8_MMA(1, 1, At, B1); PG8_BAR; PG8_SCHED;
            } else {
            PG8_LDB(B0, 0, 0); PG8_SCHED; PG8_LDA(At, 0, 0); PG8_STAGE(PG8_SA(1, 1), a1 + hstep, voffA);
            PG8_WAIT_L(8); PG8_BAR; PG8_WAIT_L(0); PG8_MMA(0, 0, At, B0); PG8_BAR; PG8_SCHED;
            PG8_LDB(B1, 0, 1); PG8_STAGE(PG8_SB(0, 0), b2, voffB);
            PG8_BAR; PG8_WAIT_L(0); PG8_MMA(0, 1, At, B1); PG8_BAR;
            PG8_LDA(At, 0, 1); PG8_STAGE(PG8_SA(0, 0), a2, voffA);
            PG8_BAR; PG8_WAIT_L(0); PG8_MMA(1, 0, At, B0); PG8_BAR; PG8_SCHED;
            PG8_STAGE(PG8_SB(0, 1), b2 + hstep, voffB);
            PG8_WAIT_V(6); PG8_BAR; PG8_MMA(1, 1, At, B1); PG8_BAR;
            PG8_LDB(B0, 1, 0); PG8_SCHED; PG8_LDA(At, 1, 0); PG8_STAGE(PG8_SA(0, 1), a2 + hstep, voffA);
            PG8_WAIT_L(8); PG8_BAR; PG8_WAIT_L(0); PG8_MMA(0, 0, At, B0); PG8_BAR; PG8_SCHED;
            PG8_LDB(B1, 1, 1); PG8_STAGE(PG8_SB(1, 0), b3, voffB);
            PG8_BAR; PG8_WAIT_L(0); PG8_MMA(0, 1, At, B1); PG8_BAR;
            PG8_LDA(At, 1, 1); PG8_STAGE(PG8_SA(1, 0), a3, voffA);
            PG8_BAR; PG8_WAIT_L(0); PG8_MMA(1, 0, At, B0); PG8_BAR; PG8_SCHED;
            PG8_STAGE(PG8_SB(1, 1), b3 + hstep, voffB);
            PG8_WAIT_V(6); PG8_BAR; PG8_MMA(1, 1, At, B1); PG8_BAR;
            }
        }
        if constexpr (ALIGN_EPI) { if (wr == 0) PG8_BAR; }
        if constexpr (!Epi::AFTER_DRAIN) { E(acc, cur, wr, wc, fr, fq); S.done(cur); }
        if (!has_next) break;
#pragma unroll
        for (int a = 0; a < 2; ++a)
#pragma unroll
            for (int b = 0; b < 2; ++b)
#pragma unroll
                for (int m = 0; m < 4; ++m)
#pragma unroll
                    for (int n = 0; n < 2; ++n) acc[a][b][m][n] = (f32x4){0.f, 0.f, 0.f, 0.f};
        cur = nxt; cA = nA; cB = nB; ++ui;
        if constexpr (ALIGN_EPI) { if (wr == 1) PG8_BAR; }
    }
    PG8_WAIT_V(0);
    if constexpr (!ALIGN_EPI) { if (wr == 0) PG8_BAR; }
    PG8_BAR;
    if constexpr (Epi::AFTER_DRAIN) { E.fused(acc, cur, wr, wc, fr, fq, lds, wid, lane); S.done(cur); }
#undef PG8_SA
#undef PG8_SB
#undef PG8_STAGE
#undef PG8_LDA
#undef PG8_LDB
#undef PG8_MMA
#undef PG8_WAIT_V
#undef PG8_WAIT_L
#undef PG8_BAR
#undef PG8_SCHED
}
}

#define LAS __attribute__((address_space(3)))
#define GAS __attribute__((address_space(1)))
typedef unsigned short bf16;
typedef unsigned v4u __attribute__((ext_vector_type(4)));
typedef unsigned v2u __attribute__((ext_vector_type(2)));
typedef float f32x4 __attribute__((ext_vector_type(4)));
typedef short bf16x8 __attribute__((ext_vector_type(8)));
typedef short s16x4 __attribute__((ext_vector_type(4)));
typedef short v4i16_t __attribute__((ext_vector_type(4)));
constexpr int BATCH = 8, SEQ = 4096, D = 1024, M = BATCH * SEQ, DFF = 2816, NH = 8, HD = 128, DEPTH = 4;
constexpr float EPS = 1e-6f;
constexpr size_t MiB = 1u << 20;
constexpr size_t WS_MOD = 1 * MiB;
constexpr size_t WS_LB = WS_MOD + 4 * 8 * 6144 * 4;
constexpr size_t WS_ROPE = 2 * MiB;
constexpr size_t WS_LSE = 6 * MiB;
constexpr size_t WS_W = 8 * MiB;
constexpr size_t W_HIN = WS_W, W_HOUT = WS_W + 16 * MiB, W_AIN = WS_W + 20 * MiB, W_AOUT = WS_W + 56 * MiB, W_FIN = WS_W + 60 * MiB, W_FOUT = WS_W + 104 * MiB;
constexpr size_t WS_U = 134 * MiB;
constexpr size_t WS_R = 198 * MiB;
constexpr size_t WS_SL = 458 * MiB;
constexpr size_t WS_AT = 472 * MiB;
constexpr size_t WS_DP = 490 * MiB;
constexpr size_t WS_END = 491 * MiB;
constexpr int LDS_BYTES = 147456;
constexpr int NWAVES = 8;

__device__ __forceinline__ unsigned pk2(float lo, float hi) { return pg8::cvt_pk_bf16_c(lo, hi); }
__device__ __forceinline__ float bflo(unsigned w) { return __builtin_bit_cast(float, w << 16); }
__device__ __forceinline__ float bfhi(unsigned w) { return __builtin_bit_cast(float, w & 0xffff0000u); }
__device__ __forceinline__ float wave_sum(float v) {
#pragma unroll
    for (int o = 1; o < 64; o <<= 1) v += __shfl_xor(v, o);
    return v;
}
#define MFMA16(a, b, c) __builtin_amdgcn_mfma_f32_16x16x32_bf16((a), (b), (c), 0, 0, 0)
__device__ __forceinline__ s16x4 tr_read(LAS const unsigned char* p) { return __builtin_bit_cast(s16x4, __builtin_amdgcn_ds_read_tr16_b64_v4i16((LAS v4i16_t*)p)); }
__device__ __forceinline__ bf16x8 cat4(s16x4 a, s16x4 b) { return __builtin_shufflevector(a, b, 0, 1, 2, 3, 4, 5, 6, 7); }
__device__ __forceinline__ bf16x8 pack_f8(const f32x4& a, const f32x4& b) { v4u w = pg8::pack8_c(a, b); return __builtin_bit_cast(bf16x8, w); }

struct TrItem { const float* W; bf16* WT; int K, N, k0, n0, drow; };
__device__ __forceinline__ void tr_load(f32x4 (&v)[16], const TrItem& t, int lane) {
    const int lr = lane >> 4, lc = lane & 15;
#pragma unroll
    for (int i = 0; i < 16; ++i) v[i] = *(const GAS f32x4*)(t.W + (size_t)(t.k0 + 4 * i + lr) * t.N + t.n0 + 4 * lc);
}
__device__ __forceinline__ void tr_emit(const f32x4 (&v)[16], const TrItem& t, LAS float* scr, int lane) {
    const int lr = lane >> 4, lc = lane & 15;
#pragma unroll
    for (int i = 0; i < 16; ++i) { LAS float* d = scr + (4 * i + lr) * 65 + 4 * lc; d[0] = v[i][0]; d[1] = v[i][1]; d[2] = v[i][2]; d[3] = v[i][3]; }
    asm volatile("s_waitcnt lgkmcnt(0)" ::: "memory");
    const int c = lane & 7;
#pragma unroll
    for (int j = 0; j < 8; ++j) { const int n = (lane >> 3) + 8 * j; const LAS float* sp = scr + (8 * c) * 65 + n;
        v4u o; o.x = pk2(sp[0 * 65], sp[1 * 65]); o.y = pk2(sp[2 * 65], sp[3 * 65]); o.z = pk2(sp[4 * 65], sp[5 * 65]); o.w = pk2(sp[6 * 65], sp[7 * 65]);
        *(GAS v4u*)(t.WT + (size_t)(t.drow + n) * t.K + t.k0 + 8 * c) = o; }
    asm volatile("s_waitcnt lgkmcnt(0)" ::: "memory");
}
__device__ __forceinline__ bool tr_family(int& it, TrItem& t, const float* W, int cnt, int K, int N, bf16* dst, size_t dstride, int mode) {
    const int nblk = N / 64, per = (K / 64) * nblk, tot = cnt * per;
    if (it >= tot) { it -= tot; return false; }
    const int mi = it / per, r = it % per, kb = r / nblk, nb = r % nblk, n0 = nb * 64; int drow = n0;
    if (mode == 1) { if (n0 < 2048) drow = 256 * ((n0 & 1023) >> 7) + 128 * (n0 >> 10) + (n0 & 127); }
    else if (mode == 2) { const int half = n0 >= DFF ? 1 : 0, jj = n0 - half * DFF; drow = 256 * (jj >> 7) + 128 * half + (jj & 127); }
    t.W = W + (size_t)mi * K * N; t.WT = dst + (size_t)mi * dstride; t.K = K; t.N = N; t.k0 = kb * 64; t.n0 = n0; t.drow = drow;
    return true;
}

struct RowRegs { f32x4 h[4]; v4u hb[2]; v4u y[2]; };
__device__ __forceinline__ void row_load(RowRegs& r, const void* hin, bool hin_f32, const bf16* Y, size_t row, int lane) {
#pragma unroll
    for (int j = 0; j < 2; ++j) {
        if (hin_f32) { const float* hp = (const float*)hin + row * D + 8 * lane + 512 * j; r.h[2 * j] = *(const GAS f32x4*)hp; r.h[2 * j + 1] = *(const GAS f32x4*)(hp + 4); }
        else r.hb[j] = *(const GAS v4u*)((const bf16*)hin + row * 2048 + 8 * lane + 512 * j);
        if (Y) r.y[j] = *(const GAS v4u*)(Y + row * D + 8 * lane + 512 * j); }
}
__device__ __forceinline__ void row_phase(const void* hin, bool hin_f32, void* hout, bool hout_f32, const bf16* Y, const float* gate, const float* ngy,
                                          bf16* U, const float* ngu, const float* sc, const float* sh, int gw, int NGW, int lane) {
    const int b = gw >> 8; const size_t row0 = (size_t)b * SEQ + (size_t)(gw & 255) * 16;
    float ysc[16], usc[16], ush[16];
#pragma unroll
    for (int j = 0; j < 2; ++j)
#pragma unroll
        for (int q = 0; q < 2; ++q) { const int col = 8 * lane + 512 * j + 4 * q;
            if (Y) { const f32x4 gt = *(const GAS f32x4*)(gate + (size_t)b * 6144 + col), ng = *(const GAS f32x4*)(ngy + col);
#pragma unroll
                for (int e = 0; e < 4; ++e) ysc[8 * j + 4 * q + e] = (1.0f + gt[e]) * ng[e]; }
            if (U) { const f32x4 ng = *(const GAS f32x4*)(ngu + col), s1 = *(const GAS f32x4*)(sc + (size_t)b * 6144 + col), s0 = *(const GAS f32x4*)(sh + (size_t)b * 6144 + col);
#pragma unroll
                for (int e = 0; e < 4; ++e) { usc[8 * j + 4 * q + e] = ng[e] * (1.0f + s1[e]); ush[8 * j + 4 * q + e] = s0[e]; } } }
    RowRegs cur, nxt, nx2;
    row_load(cur, hin, hin_f32, Y, row0, lane); row_load(nxt, hin, hin_f32, Y, row0 + 1, lane);
#pragma unroll
    for (int k = 0; k < 16; ++k) {
        const size_t row = row0 + k;
        if (k + 2 < 16) row_load(nx2, hin, hin_f32, Y, row + 2, lane);
        float hv[16];
#pragma unroll
        for (int j = 0; j < 2; ++j)
#pragma unroll
            for (int e = 0; e < 4; ++e) {
                if (hin_f32) { hv[8 * j + e] = cur.h[2 * j][e]; hv[8 * j + 4 + e] = cur.h[2 * j + 1][e]; }
                else { hv[8 * j + 2 * e] = bflo(cur.hb[j][e]); hv[8 * j + 2 * e + 1] = bfhi(cur.hb[j][e]); } }
        if (Y) {
            float yv[16]; float ss = 0.f;
#pragma unroll
            for (int j = 0; j < 2; ++j)
#pragma unroll
                for (int e = 0; e < 4; ++e) { yv[8 * j + 2 * e] = bflo(cur.y[j][e]); yv[8 * j + 2 * e + 1] = bfhi(cur.y[j][e]); }
#pragma unroll
            for (int e = 0; e < 16; ++e) ss += yv[e] * yv[e];
            const float rstd = __builtin_amdgcn_rsqf(wave_sum(ss) * (1.0f / D) + EPS);
#pragma unroll
            for (int e = 0; e < 16; ++e) hv[e] += ysc[e] * (yv[e] * rstd);
#pragma unroll
            for (int j = 0; j < 2; ++j) {
                if (hout_f32) { float* op = (float*)hout + row * D + 8 * lane + 512 * j;
                    *(GAS f32x4*)op = (f32x4){hv[8 * j], hv[8 * j + 1], hv[8 * j + 2], hv[8 * j + 3]}; *(GAS f32x4*)(op + 4) = (f32x4){hv[8 * j + 4], hv[8 * j + 5], hv[8 * j + 6], hv[8 * j + 7]}; }
                else { v4u w; w.x = pk2(hv[8 * j], hv[8 * j + 1]); w.y = pk2(hv[8 * j + 2], hv[8 * j + 3]); w.z = pk2(hv[8 * j + 4], hv[8 * j + 5]); w.w = pk2(hv[8 * j + 6], hv[8 * j + 7]);
                    *(GAS v4u*)((bf16*)hout + row * 2048 + 8 * lane + 512 * j) = w;
#pragma unroll
                    for (int e = 0; e < 4; ++e) { hv[8 * j + 2 * e] = bflo(w[e]); hv[8 * j + 2 * e + 1] = bfhi(w[e]); } }
            }
        }
        if (U) {
            float ss = 0.f;
#pragma unroll
            for (int e = 0; e < 16; ++e) ss += hv[e] * hv[e];
            const float rstd = __builtin_amdgcn_rsqf(wave_sum(ss) * (1.0f / D) + EPS);
#pragma unroll
            for (int j = 0; j < 2; ++j) { float uv[8];
#pragma unroll
                for (int e = 0; e < 8; ++e) uv[e] = hv[8 * j + e] * rstd * usc[8 * j + e] + ush[8 * j + e];
                v4u w; w.x = pk2(uv[0], uv[1]); w.y = pk2(uv[2], uv[3]); w.z = pk2(uv[4], uv[5]); w.w = pk2(uv[6], uv[7]);
                *(GAS v4u*)(U + row * D + 8 * lane + 512 * j) = w; }
        }
        cur = nxt; nxt = nx2;
    }
}

struct ScanSet { v4u q, k, v; f32x4 d; };
struct ScanAux { v2u g0, g1; };
#define GLD(T, base, off) (*(const GAS T*)((const GAS char*)(base) + (unsigned)(off)))
#define GST(T, base, off) (*(GAS T*)((GAS char*)(base) + (unsigned)(off)))
template <bool WQ>
__device__ __forceinline__ void scan_load(ScanSet& s, const bf16* QD, const bf16* KI, const bf16* VV, const float* DEC, unsigned offq, unsigned offd, int c, int cend, int tid) {
    if (c < cend) { const unsigned o = offq + (unsigned)c * 65536u; if (WQ) s.q = GLD(v4u, QD, o); s.k = GLD(v4u, KI, o); s.v = GLD(v4u, VV, o);
        if (tid < 32) s.d = GLD(f32x4, DEC, offd + (unsigned)c * 4096u); }
}
__device__ __forceinline__ void aux_load(ScanAux& s, const bf16* GG, const bf16* AT, unsigned offg, unsigned offa, int c, int cend) {
    if (c < cend) { const unsigned o = offg + (unsigned)c * 65536u; s.g0 = GLD(v2u, GG, o); s.g1 = GLD(v2u, GG, o + 32768u);
                    }
}
template <bool WQ>
__device__ __forceinline__ void scan_store(const ScanSet& s, LAS unsigned char* B, int lrow, int lch, int tid) {
    constexpr int PITCH = 288, TB = 32 * PITCH, DOFF = 3 * TB;
    LAS unsigned char* d = B + lrow * PITCH + lch * 16; if (WQ) *(LAS v4u*)(B + lrow * 272 + lch * 16) = s.q; *(LAS v4u*)(d + TB) = s.k; *(LAS v4u*)(d + 2 * TB) = s.v; if (tid < 32) *(LAS f32x4*)(B + DOFF + tid * 16) = s.d;
}
#define SCAN_UPDATE(B0, VB) do { \
          _Pragma("unroll") for (int kt = 0; kt < 8; ++kt) { LAS const unsigned char* pkk = (B0) + TB + (4 * g + q4) * PITCH + (16 * kt + 4 * p4) * 2; const bf16x8 kf = cat4(tr_read(pkk), tr_read(pkk + 16 * PITCH)); \
              S[kt] = MFMA16(kf, VB, S[kt]); const f32x4 dv = *(LAS const f32x4*)((B0) + DOFF + (16 * kt + 4 * g) * 4); S[kt] = S[kt] * dv; } } while (0)
#define SCAN_VFRAG(B0) cat4(tr_read((B0) + 2 * TB + (4 * g + q4) * PITCH + (16 * wave + 4 * p4) * 2), tr_read((B0) + 2 * TB + (20 * 1 + 4 * g + q4 - 4) * PITCH + (16 * wave + 4 * p4) * 2))
__device__ __forceinline__ void hgrn_passA(LAS unsigned char* L, const bf16* QD, const bf16* KI, const bf16* VV, const float* DEC, float* SL, bf16* AT, float* DP, int tid, int wave, int lane) {
    constexpr int PITCH = 288, TB = 32 * PITCH, BUF = 28672, DOFF = 3 * TB;
    const int bh = blockIdx.x >> 2, seg = blockIdx.x & 3, b = bh >> 3, h = bh & 7, fr = lane & 15, g = lane >> 4, q4 = fr >> 2, p4 = fr & 3;
    const unsigned rowbase = (unsigned)b * SEQ * D + h * HD;
    const int lrow = tid >> 4, lch = tid & 15, c0 = seg * 32, cend = c0 + 32;
    const unsigned offq = (rowbase + lrow * D + lch * 8) * 2u, offd = ((unsigned)(b * 128) * D + h * HD + tid * 4) * 4u, offa = ((unsigned)(bh * 128) * 64 + lane) * 32u;
    if (seg == 3) return;
    if (tid < 128) { float p = 1.0f;
#pragma unroll 8
        for (int i = 0; i < 32; ++i) p *= *(const GAS float*)(DEC + (size_t)(b * 128 + c0 + i) * D + h * HD + tid);
        *(GAS float*)(DP + (size_t)(bh * 3 + seg) * 128 + tid) = p; }
    f32x4 S[8];
#pragma unroll
    for (int i = 0; i < 8; ++i) S[i] = (f32x4){0.f, 0.f, 0.f, 0.f};
    ScanSet s0, s1, s2, s3;
    scan_load<false>(s0, QD, KI, VV, DEC, offq, offd, c0, cend, tid); scan_load<false>(s1, QD, KI, VV, DEC, offq, offd, c0 + 1, cend, tid);
    scan_load<false>(s2, QD, KI, VV, DEC, offq, offd, c0 + 2, cend, tid); scan_load<false>(s3, QD, KI, VV, DEC, offq, offd, c0 + 3, cend, tid);
    scan_store<false>(s0, L, lrow, lch, tid);
    __syncthreads();
#define PA_ITER(i, CUR, NXT) do { const int c = c0 + (i); \
        LAS unsigned char* B0 = L + ((i) & 1) * BUF; LAS unsigned char* B1 = L + (((i) & 1) ^ 1) * BUF; \
        scan_load<false>(CUR, QD, KI, VV, DEC, offq, offd, c + 4, cend, tid); \
        { const bf16x8 vb_ = SCAN_VFRAG(B0); SCAN_UPDATE(B0, vb_); } \
        if ((i) + 1 < 32) scan_store<false>(NXT, B1, lrow, lch, tid); \
        __syncthreads(); } while (0)
#pragma unroll
    for (int i4 = 0; i4 < 32; i4 += 4) { PA_ITER(i4, s0, s1); PA_ITER(i4 + 1, s1, s2); PA_ITER(i4 + 2, s2, s3); PA_ITER(i4 + 3, s3, s0); }
#undef PA_ITER
    if (seg < 3) {
#pragma unroll
        for (int kt = 0; kt < 8; ++kt) *(GAS f32x4*)(SL + (((size_t)(bh * 3 + seg) * 8 + kt) * 512 + tid) * 4) = S[kt]; }
}
__device__ __forceinline__ void hgrn_passB(LAS unsigned char* L, const bf16* QD, const bf16* KI, const bf16* VV, const bf16* GG, const float* DEC, const float* SL, const bf16* AT, const float* DP,
                                           const float* ngh, bf16* Uo, int tid, int wave, int lane) {
    constexpr int PITCH = 288, TB = 32 * PITCH, BUF = 28672, DOFF = 3 * TB, SSOFF = 2 * BUF;
    const int bh = blockIdx.x >> 2, seg = blockIdx.x & 3, b = bh >> 3, h = bh & 7, fr = lane & 15, g = lane >> 4, q4 = fr >> 2, p4 = fr & 3;
    const unsigned rowbase = (unsigned)b * SEQ * D + h * HD;
    const int lrow = tid >> 4, lch = tid & 15, c0 = seg * 32, cend = c0 + 32;
    const unsigned offq = (rowbase + lrow * D + lch * 8) * 2u, offd = ((unsigned)(b * 128) * D + h * HD + tid * 4) * 4u, offa = ((unsigned)(bh * 128) * 64 + lane) * 32u, offg = (rowbase + fr * D + 16 * wave + 4 * g) * 2u;
    ScanSet s0, s1, s2, s3;
    scan_load<true>(s0, QD, KI, VV, DEC, offq, offd, c0, cend, tid); scan_load<true>(s1, QD, KI, VV, DEC, offq, offd, c0 + 1, cend, tid);
    scan_load<true>(s2, QD, KI, VV, DEC, offq, offd, c0 + 2, cend, tid); scan_load<true>(s3, QD, KI, VV, DEC, offq, offd, c0 + 3, cend, tid);
    ScanAux xa, xb; aux_load(xa, GG, AT, offg, offa, c0, cend); xb = xa;
    f32x4 S[8];
#pragma unroll
    for (int kt = 0; kt < 8; ++kt) S[kt] = (f32x4){0.f, 0.f, 0.f, 0.f};
    if (seg >= 1) {
#pragma unroll
        for (int kt = 0; kt < 8; ++kt) S[kt] = *(const GAS f32x4*)(SL + (((size_t)(bh * 3 + 0) * 8 + kt) * 512 + tid) * 4);
        for (int i = 1; i < seg; ++i) {
#pragma unroll
            for (int kt = 0; kt < 8; ++kt) { const f32x4 dv = *(const GAS f32x4*)(DP + (size_t)(bh * 3 + i) * 128 + 16 * kt + 4 * g), lv = *(const GAS f32x4*)(SL + (((size_t)(bh * 3 + i) * 8 + kt) * 512 + tid) * 4);
                S[kt] = S[kt] * dv + lv; } }
    }
    scan_store<true>(s0, L, lrow, lch, tid);
    __syncthreads();
    const f32x4 ngv = *(const GAS f32x4*)(ngh + h * HD + 16 * wave + 4 * g);
#define PB_ITER(i, CUR, NXT, XC, XN) do { const int c = c0 + (i); \
        LAS unsigned char* B0 = L + ((i) & 1) * BUF; LAS unsigned char* B1 = L + (((i) & 1) ^ 1) * BUF; \
        const v2u gt0 = XC.g0, gt1 = XC.g1; \
        aux_load(XN, GG, AT, offg, offa, c + 1, cend); \
        scan_load<true>(CUR, QD, KI, VV, DEC, offq, offd, c + 4, cend, tid); \
        f32x4 o[2] = {(f32x4){0.f, 0.f, 0.f, 0.f}, (f32x4){0.f, 0.f, 0.f, 0.f}}; f32x4 a00 = {0.f, 0.f, 0.f, 0.f}, a01 = {0.f, 0.f, 0.f, 0.f}, a11 = {0.f, 0.f, 0.f, 0.f}; \
        _Pragma("unroll") for (int ks = 0; ks < 4; ++ks) { const bf16x8 sf = pack_f8(S[2 * ks], S[2 * ks + 1]); \
            LAS const unsigned char* p = B0 + fr * 272 + (32 * ks + 4 * g) * 2; LAS const unsigned char* pk_ = B0 + TB + fr * PITCH + (32 * ks + 4 * g) * 2; \
            const bf16x8 q0 = cat4(*(LAS const s16x4*)p, *(LAS const s16x4*)(p + 32)), q1 = cat4(*(LAS const s16x4*)(p + 16 * 272), *(LAS const s16x4*)(p + 16 * 272 + 32)); \
            const bf16x8 k0 = cat4(*(LAS const s16x4*)pk_, *(LAS const s16x4*)(pk_ + 32)), k1 = cat4(*(LAS const s16x4*)(pk_ + 16 * PITCH), *(LAS const s16x4*)(pk_ + 16 * PITCH + 32)); \
            o[0] = MFMA16(sf, q0, o[0]); o[1] = MFMA16(sf, q1, o[1]); a00 = MFMA16(k0, q0, a00); a01 = MFMA16(k0, q1, a01); a11 = MFMA16(k1, q1, a11); } \
        _Pragma("unroll") for (int r = 0; r < 4; ++r) if (4 * g + r > fr) { a00[r] = 0.f; a11[r] = 0.f; } \
        const bf16x8 pf0 = pack_f8(a00, (f32x4){0.f, 0.f, 0.f, 0.f}), pf1 = pack_f8(a01, a11); \
        { const bf16x8 vf = SCAN_VFRAG(B0); o[0] = MFMA16(vf, pf0, o[0]); o[1] = MFMA16(vf, pf1, o[1]); SCAN_UPDATE(B0, vf); } \
        _Pragma("unroll") for (int ct = 0; ct < 2; ++ct) { float ss = o[ct][0] * o[ct][0] + o[ct][1] * o[ct][1] + o[ct][2] * o[ct][2] + o[ct][3] * o[ct][3]; ss += __shfl_xor(ss, 16); ss += __shfl_xor(ss, 32); \
            if (g == 0) *(LAS float*)(L + SSOFF + (((i) & 1) * 32 + 16 * ct + fr) * 32 + wave * 4) = ss; } \
        if ((i) + 1 < 32) scan_store<true>(NXT, B1, lrow, lch, tid); \
        __syncthreads(); \
        _Pragma("unroll") for (int ct = 0; ct < 2; ++ct) { LAS const unsigned char* sp = L + SSOFF + (((i) & 1) * 32 + 16 * ct + fr) * 32; const f32x4 t0 = *(LAS const f32x4*)sp, t1 = *(LAS const f32x4*)(sp + 16); \
            const float tot = ((t0[0] + t0[1]) + (t0[2] + t0[3])) + ((t1[0] + t1[1]) + (t1[2] + t1[3])); \
            const float rstd = __builtin_amdgcn_rsqf(tot * (1.0f / HD) + EPS); const v2u gt = ct ? gt1 : gt0; \
            f32x4 r; r[0] = o[ct][0] * rstd * ngv[0] * bflo(gt.x); r[1] = o[ct][1] * rstd * ngv[1] * bfhi(gt.x); r[2] = o[ct][2] * rstd * ngv[2] * bflo(gt.y); r[3] = o[ct][3] * rstd * ngv[3] * bfhi(gt.y); \
            GST(v2u, Uo, offg + (unsigned)c * 65536u + (unsigned)ct * 32768u) = pg8::pack4_c(r); } \
    } while (0)
#pragma unroll
    for (int i4 = 0; i4 < 32; i4 += 4) { PB_ITER(i4, s0, s1, xa, xb); PB_ITER(i4 + 1, s1, s2, xb, xa); PB_ITER(i4 + 2, s2, s3, xa, xb); PB_ITER(i4 + 3, s3, s0, xb, xa); }
#undef PB_ITER
}

#define ATT_DECODE(un_, uu_, b_, h_, r_, n_) const int un_ = blockIdx.x * 8 + (uu_), b_ = un_ >> 8, h_ = (un_ >> 5) & 7, r_ = (un_ & 31) >> (5 - lg), n_ = (un_ & 31) & ((32 >> lg) - 1)
__device__ __forceinline__ void attn_group(LAS unsigned char* L, const bf16* Q, const bf16* K, const bf16* V, bf16* ORUN, float* LSE, const int lg, int tid, int wave, int lane) {
    constexpr int KP = 272, VP = 288, VOFF = 256 * KP; const bool first = (lg == 0);
    const int fr = lane & 15, g = lane >> 4, q4 = fr >> 2, p4 = fr & 3, lk = tid >> 4, ch = tid & 15;
    const float NEG = -__builtin_inff();
    v4u ck[4], cv[4]; bf16x8 qn[4];
    { ATT_DECODE(ua, 0, b, h, r, n);
      { const size_t qrow0 = (size_t)(b * SEQ + ((128 * n + 16 * wave + fr) << lg) + r);
#pragma unroll
        for (int ks = 0; ks < 4; ++ks) qn[ks] = *(const GAS bf16x8*)(Q + qrow0 * D + h * HD + 32 * ks + 8 * g); }
#pragma unroll
      for (int pass = 0; pass < 4; ++pass) { const size_t src = (size_t)(b * SEQ + ((128 * n + pass * 32 + lk) << lg) + r) * D + h * HD + ch * 8; ck[pass] = *(const GAS v4u*)(K + src); cv[pass] = *(const GAS v4u*)(V + src); } }
#pragma unroll 1
    for (int uu = 0; uu < 8; ++uu) {
        ATT_DECODE(ub, uu, b, h, r, n);
        const int flip = ((uu & 1) ^ 1) << 7;
        __syncthreads();
#pragma unroll
        for (int pass = 0; pass < 4; ++pass) { const int pk = (128 + pass * 32 + lk) ^ flip; *(LAS v4u*)(L + pk * KP + ch * 16) = ck[pass]; *(LAS v4u*)(L + VOFF + pk * VP + ch * 16) = cv[pass]; }
        if (n == 0) {
#pragma unroll
            for (int pass = 0; pass < 4; ++pass) { const int pk = (pass * 32 + lk) ^ flip; *(LAS v4u*)(L + VOFF + pk * VP + ch * 16) = (v4u){0, 0, 0, 0}; }
        } else if (uu == 0) {
#pragma unroll
            for (int pass = 0; pass < 4; ++pass) { const int kk = pass * 32 + lk, pk = kk ^ flip; const size_t src = (size_t)(b * SEQ + ((128 * (n - 1) + kk) << lg) + r) * D + h * HD + ch * 8;
                *(LAS v4u*)(L + pk * KP + ch * 16) = *(const GAS v4u*)(K + src); *(LAS v4u*)(L + VOFF + pk * VP + ch * 16) = *(const GAS v4u*)(V + src); }
        }
        const int qi = 16 * wave + fr; const size_t qrow = (size_t)(b * SEQ + ((128 * n + qi) << lg) + r);
        bf16x8 qf[4];
#pragma unroll
        for (int ks = 0; ks < 4; ++ks) qf[ks] = qn[ks];
        __syncthreads();
        if (uu + 1 < 8) { ATT_DECODE(uc, uu + 1, b2, h2, r2, n2);
            { const size_t qrow2 = (size_t)(b2 * SEQ + ((128 * n2 + 16 * wave + fr) << lg) + r2);
#pragma unroll
              for (int ks = 0; ks < 4; ++ks) qn[ks] = *(const GAS bf16x8*)(Q + qrow2 * D + h2 * HD + 32 * ks + 8 * g); }
#pragma unroll
            for (int pass = 0; pass < 4; ++pass) { const size_t src = (size_t)(b2 * SEQ + ((128 * n2 + pass * 32 + lk) << lg) + r2) * D + h2 * HD + ch * 8; ck[pass] = *(const GAS v4u*)(K + src); cv[pass] = *(const GAS v4u*)(V + src); } }
        const int kt0 = (16 * wave < 96) ? 16 * wave : 96;
        f32x4 s[10];
#pragma unroll
        for (int t = 0; t < 10; ++t) { s[t] = (f32x4){0.f, 0.f, 0.f, 0.f}; const int ki0 = kt0 + 16 * t, rowb = (ki0 ^ flip) + fr;
            const bool none = (ki0 + 15 < 16 * wave) || (ki0 > 16 * wave + 143) || (n == 0 && ki0 < 128);
            if (!none) {
#pragma unroll
                for (int ks = 0; ks < 4; ++ks) { const bf16x8 a = *(LAS const bf16x8*)(L + rowb * KP + ks * 64 + g * 16); s[t] = MFMA16(a, qf[ks], s[t]); } } }
        bf16* op = ORUN + qrow * D + h * HD + 4 * g;
        float lo = 0.f; v2u pr[8];
        if (!first) { lo = ((const GAS float*)LSE)[qrow * 8 + h];
#pragma unroll
            for (int dt = 0; dt < 8; ++dt) pr[dt] = *(const GAS v2u*)(op + 16 * dt); }
        float mx = NEG;
#pragma unroll
        for (int t = 0; t < 10; ++t) { const int ki0 = kt0 + 16 * t;
            const bool none = (ki0 + 15 < 16 * wave) || (ki0 > 16 * wave + 143) || (n == 0 && ki0 < 128);
            const bool full = (ki0 >= 16 * wave + 16) && (ki0 <= 16 * wave + 112) && (n > 0 || ki0 >= 128);
            if (none) { s[t] = (f32x4){NEG, NEG, NEG, NEG}; }
            else if (full) { mx = fmaxf(fmaxf(mx, fmaxf(s[t][0], s[t][1])), fmaxf(s[t][2], s[t][3])); }
            else {
#pragma unroll
                for (int rg = 0; rg < 4; ++rg) { const int ki = ki0 + 4 * g + rg; const bool ok = (ki >= qi) && (ki <= qi + 128);
                    s[t][rg] = ok ? s[t][rg] : NEG; mx = fmaxf(mx, s[t][rg]); } } }
        mx = fmaxf(mx, __shfl_xor(mx, 16)); mx = fmaxf(mx, __shfl_xor(mx, 32));
        float z = 0.f; const float mxl = -mx * 1.4426950408889634f;
#pragma unroll
        for (int t = 0; t < 10; ++t)
#pragma unroll
            for (int rg = 0; rg < 4; ++rg) { const float p = __builtin_amdgcn_exp2f(__builtin_fmaf(s[t][rg], 1.4426950408889634f, mxl)); s[t][rg] = p; z += p; }
        z += __shfl_xor(z, 16); z += __shfl_xor(z, 32);
        f32x4 o[8];
#pragma unroll
        for (int dt = 0; dt < 8; ++dt) o[dt] = (f32x4){0.f, 0.f, 0.f, 0.f};
#pragma unroll
        for (int j = 0; j < 5; ++j) { const bf16x8 pf = pack_f8(s[2 * j], s[2 * j + 1]);
            const int r0 = ((kt0 + 32 * j) ^ flip) + 4 * g + q4, r1 = ((kt0 + 32 * j + 16) ^ flip) + 4 * g + q4;
#pragma unroll
            for (int dt = 0; dt < 8; ++dt) { const bf16x8 vf = cat4(tr_read(L + VOFF + r0 * VP + (16 * dt + 4 * p4) * 2), tr_read(L + VOFF + r1 * VP + (16 * dt + 4 * p4) * 2)); o[dt] = MFMA16(vf, pf, o[dt]); } }
        float lse = mx + __logf(z), w_new = 1.0f / z, w_old = 0.f;
        if (!first) { const float mm = fmaxf(lo, lse), e1 = __expf(lo - mm), e2 = __expf(lse - mm), den = e1 + e2; w_old = e1 / den; w_new = w_new * e2 / den; lse = mm + __logf(den); }
#pragma unroll
        for (int dt = 0; dt < 8; ++dt) { f32x4 rr = o[dt] * w_new;
            if (!first) { rr[0] += w_old * bflo(pr[dt].x); rr[1] += w_old * bfhi(pr[dt].x); rr[2] += w_old * bflo(pr[dt].y); rr[3] += w_old * bfhi(pr[dt].y); }
            *(GAS v2u*)(op + 16 * dt) = pg8::pack4_c(rr); }
        if (g == 0 && lg < 4) ((GAS float*)LSE)[qrow * 8 + h] = lse;
    }
}
#ifndef SKIP_HG
#define SKIP_HG 0
#endif
#ifndef SKIP_SCAN
#define SKIP_SCAN 0
#endif
#ifndef SKIP_ROPE
#define SKIP_ROPE 0
#endif
#ifndef SKIP_ATT
#define SKIP_ATT 0
#endif
#ifndef SKIP_SWI
#define SKIP_SWI 0
#endif
#ifndef SKIP_PLAIN
#define SKIP_PLAIN 0
#endif
#ifndef SKIP_P0
#define SKIP_P0 0
#endif


#ifndef PROBE
#define PROBE 0
#endif
#define PSCALE 0.25f
#if PROBE
#define TS_INIT() do { if (blockIdx.x == 0 && threadIdx.x == 0) { for (int i_ = 0; i_ < 12; ++i_) *(LAS float*)(L + 144000 + 4 * i_) = 0.f; *(LAS unsigned long long*)(L + 144064) = __builtin_amdgcn_s_memrealtime(); } } while (0)
#define TS(cat) do { if (blockIdx.x == 0 && threadIdx.x == 0) { const unsigned long long t_ = __builtin_amdgcn_s_memrealtime(); const unsigned long long p_ = *(LAS unsigned long long*)(L + 144064); \
    *(LAS float*)(L + 144000 + 4 * (cat)) += (float)(t_ - p_) * 0.01f; *(LAS unsigned long long*)(L + 144064) = t_; } } while (0)
#else
#define TS_INIT() do {} while (0)
#define TS(cat) do {} while (0)
#endif
#define XB_TMO      128
#define XB_XCNT(j)  (256  + 64 * (j))
#define XB_XSUB(j)  (1280 + 64 * (j))
#define XB_XGEN(j)  (2304 + 64 * (j))
#define XB_TOP      3328
#define XB_TOPGEN   3392
#define XCD_BAR_WORDS 3456
#define XB_SPIN_CAP (1u << 18)

__device__ __forceinline__ unsigned xb_ld(unsigned* p)              { return __hip_atomic_load(p, __ATOMIC_RELAXED, __HIP_MEMORY_SCOPE_AGENT); }
__device__ __forceinline__ unsigned xb_add(unsigned* p, unsigned v) { return __hip_atomic_fetch_add(p, v, __ATOMIC_RELAXED, __HIP_MEMORY_SCOPE_AGENT); }
__device__ __forceinline__ unsigned xb_xcc_id() { return (unsigned)__builtin_amdgcn_s_getreg((3 << 11) | 20) & 0xFu; }
#define XB_SPIN(cond, bar) do { unsigned _sp = 0; while (cond) { __builtin_amdgcn_s_sleep(1); \
    if ((++_sp & 255u) == 0u) { if (xb_ld(&(bar)[XB_TMO])) break; if (_sp > XB_SPIN_CAP) { atomicAdd(&(bar)[XB_TMO], 1u); break; } } } } while (0)

struct XcdBarrier {
    unsigned* bar; unsigned x;
    volatile LAS unsigned* st;
};

__device__ __forceinline__ XcdBarrier xcd_barrier_post(unsigned* bar, volatile LAS unsigned* st) {
    XcdBarrier b; b.bar = bar; b.x = xb_xcc_id(); b.st = st;
    if (threadIdx.x == 0) (void)xb_add(&bar[XB_XCNT(b.x)], 1u);
    return b;
}
__device__ __forceinline__ void xcd_barrier_complete(unsigned* bar, unsigned x, unsigned& nloc, unsigned& nx) {
    const unsigned G = gridDim.x * gridDim.y * gridDim.z;
    unsigned sum, cnt, mine, sp = 0u;
    for (;;) {
        sum = 0u; cnt = 0u; mine = 0u;
#pragma unroll
        for (unsigned j = 0; j < 16; ++j) { const unsigned c = xb_ld(&bar[XB_XCNT(j)]); sum += c; cnt += (c > 0u) ? 1u : 0u; mine = (j == x) ? c : mine; }
        if (sum == G) break;
        __builtin_amdgcn_s_sleep(1);
        if ((++sp & 255u) == 0u) { if (xb_ld(&bar[XB_TMO])) break; if (sp > XB_SPIN_CAP) { atomicAdd(&bar[XB_TMO], 1u); break; } }
    }
    nloc = mine > 0u ? mine : 1u; nx = cnt > 0u ? cnt : 1u;
}

__device__ __forceinline__ void xcd_barrier(const XcdBarrier& b) {
    asm volatile("s_waitcnt vmcnt(0)" ::: "memory");
    __syncthreads();
    if (threadIdx.x == 0) {
        unsigned* bar = b.bar;
        __builtin_amdgcn_s_waitcnt(0);
        unsigned nloc = b.st[0], nx = b.st[1];
        if (nloc == 0u) { xcd_barrier_complete(bar, b.x, nloc, nx); b.st[0] = nloc; b.st[1] = nx; }
        const unsigned old = xb_add(&bar[XB_XSUB(b.x)], 1u);
        const unsigned gen = old / nloc;
        if (old + 1u == (gen + 1u) * nloc) {
            __builtin_amdgcn_fence(__ATOMIC_RELEASE, "agent");
            asm volatile("s_waitcnt vmcnt(0)" ::: "memory");
            const unsigned og = xb_add(&bar[XB_TOP], 1u);
            const unsigned tg = og / nx;
            if (og + 1u == (tg + 1u) * nx) xb_add(&bar[XB_TOPGEN], 1u);
            else XB_SPIN(xb_ld(&bar[XB_TOPGEN]) == tg, bar);
            __builtin_amdgcn_fence(__ATOMIC_ACQUIRE, "agent");
            xb_add(&bar[XB_XGEN(b.x)], 1u);
            asm volatile("s_waitcnt vmcnt(0)" ::: "memory");
        } else {
            XB_SPIN(xb_ld(&bar[XB_XGEN(b.x)]) == gen, bar);
            __builtin_amdgcn_fence(__ATOMIC_ACQUIRE, "agent");
            asm volatile("s_waitcnt vmcnt(0)" ::: "memory");
        }
    }
    __syncthreads();
}

struct Args { const void* in[14]; float* out; unsigned char* ws; };
#define GEMM_PHASE(EpiT, Eobj, Aptr, Bptr, N_, K_) do { pg8::Gemm g_{(const pg8::bf16_t*)(Aptr), (const pg8::bf16_t*)(Bptr), M, (N_), (K_)}; pg8::StaticOrder S_; S_.init(M, (N_), G, (int)blockIdx.x); \
    pg8::gemm_phase<EpiT, pg8::StaticOrder, true, true>(L, g_, S_, Eobj); } while (0)

__device__ __forceinline__ unsigned char* opq(unsigned char* p) { asm volatile("" : "+s"(p)); return p; }
__device__ __forceinline__ const float* opqf(const void* p) { const float* q = (const float*)p; asm volatile("" : "+s"(q)); return q; }
__global__ void __launch_bounds__(NWAVES * 64, 2) fwd_kernel(Args a) {
    extern __shared__ __attribute__((aligned(16))) unsigned char lds_raw[];
    cg::grid_group grid = cg::this_grid();
    LAS unsigned char* L = (LAS unsigned char*)lds_raw;
    const int G = gridDim.x, NGW = G * NWAVES;
#define FRESH_IDS int tid = threadIdx.x; asm volatile("" : "+v"(tid)); const int lane = tid & 63, wave = __builtin_amdgcn_readfirstlane(tid >> 6), gw = blockIdx.x * NWAVES + wave; (void)lane; (void)wave; (void)gw;
#define WSB(off) (opq(a.ws) + (off))
#define MODP ((float*)WSB(WS_MOD))
#define LBP ((float*)WSB(WS_LB))
#define CSP ((float*)WSB(WS_ROPE))
#define SNP ((float*)WSB(WS_ROPE + (size_t)M * 16 * 4))
#define LSEP ((float*)WSB(WS_LSE))
#define UP ((bf16*)WSB(WS_U))
#define T0P ((bf16*)WSB(WS_R))
#define T1P ((bf16*)WSB(WS_R + 64 * MiB))
#define T2P ((bf16*)WSB(WS_R + 128 * MiB))
#define T3P ((bf16*)WSB(WS_R + 192 * MiB))
#define DECP ((float*)WSB(WS_R + 256 * MiB))
#define GSYNC() do { XcdBarrier xb_; xb_.bar = (unsigned*)opq(a.ws); xb_.x = xb_xcc_id(); xb_.st = (volatile LAS unsigned*)(L + 144128); xcd_barrier(xb_); } while (0)
    if (threadIdx.x < 2) ((LAS unsigned*)(L + 144128))[threadIdx.x] = 0u;
    __syncthreads();
    (void)xcd_barrier_post((unsigned*)opq(a.ws), (volatile LAS unsigned*)(L + 144128));
    TS_INIT();
    if (!SKIP_P0) { FRESH_IDS
        const float* cin = (const float*)a.in[1]; const int* pos = (const int*)a.in[2]; const float* ada_w = (const float*)a.in[3]; const float* ada_b = (const float*)a.in[4]; const float* lbraw = (const float*)a.in[7];
        float* MOD = MODP; float* LB = LBP; float* CS = CSP; float* SN = SNP; unsigned char* ws = a.ws;
        LAS float* condL = (LAS float*)L; LAS float* part = (LAS float*)(L + 32768);
        for (int i = tid; i < BATCH * D; i += NWAVES * 64) { const float v = cin[i]; condL[i] = v / (1.0f + expf(-v)); }
        __syncthreads();
        for (int item = blockIdx.x; item < 4 * 96; item += G) {
            const int l = item / 96, cc = item % 96, col = cc * 64 + lane;
            const float* wp = ada_w + ((size_t)l * D + wave * 128) * 6144 + col;
            float acc[8];
#pragma unroll
            for (int bb = 0; bb < 8; ++bb) acc[bb] = 0.f;
#pragma unroll 32
            for (int k = 0; k < 128; ++k) { const float w = ((const GAS float*)wp)[(size_t)k * 6144];
#pragma unroll
                for (int bb = 0; bb < 8; ++bb) acc[bb] += condL[bb * D + wave * 128 + k] * w; }
#pragma unroll
            for (int bb = 0; bb < 8; ++bb) part[(wave * 8 + bb) * 64 + lane] = acc[bb];
            __syncthreads();
            { const int bb = tid >> 6; float s = 0.f;
#pragma unroll
              for (int w2 = 0; w2 < 8; ++w2) s += part[(w2 * 8 + bb) * 64 + lane];
              MOD[(size_t)(l * 8 + bb) * 6144 + cc * 64 + lane] = s + ada_b[l * 6144 + cc * 64 + lane]; }
            __syncthreads();
        }
        if (blockIdx.x == 0) for (int i = tid; i < D; i += NWAVES * 64) { LB[i] = 0.f; LB[D + i] = 1.0f / (1.0f + expf(-(lbraw[D + i] - lbraw[i]))); }
        const float invf = (float)pow(500000.0, -(double)(tid & 15) / 16.0);
        for (int i = blockIdx.x * (NWAVES * 64) + tid; i < M * 16; i += G * NWAVES * 64) {
            const int m = i >> 4; const float ang = (float)pos[m] * invf;
            CS[i] = cosf(ang); SN[i] = sinf(ang); }
        __syncthreads();
        LAS float* scr = (LAS float*)(L + wave * 16640);
#define TR_DECODE(idx_, t_) do { int it_ = (idx_); \
            if (tr_family(it_, t_, (const float*)a.in[6], 2, D, 4 * D, (bf16*)(ws + W_HIN), (size_t)4 * D * D, 1)) break; \
            if (tr_family(it_, t_, (const float*)a.in[9], 2, D, D, (bf16*)(ws + W_HOUT), (size_t)D * D, 0)) break; \
            if (tr_family(it_, t_, (const float*)a.in[10], 2, D, 9 * D, (bf16*)(ws + W_AIN), (size_t)9 * D * D, 0)) break; \
            if (tr_family(it_, t_, (const float*)a.in[11], 2, D, D, (bf16*)(ws + W_AOUT), (size_t)D * D, 0)) break; \
            if (tr_family(it_, t_, (const float*)a.in[12], 4, D, 2 * DFF, (bf16*)(ws + W_FIN), (size_t)2 * DFF * D, 2)) break; \
            (void)tr_family(it_, t_, (const float*)a.in[13], 4, DFF, D, (bf16*)(ws + W_FOUT), (size_t)DFF * D, 0); } while (0)
        { TrItem tc, tn; f32x4 vc[16], vn[16]; int it0 = gw;
          if (it0 < 16128) { TR_DECODE(it0, tc); tr_load(vc, tc, lane); }
#pragma unroll 1
          while (it0 < 16128) { const int itn = it0 + NGW; const bool hn = itn < 16128;
              if (hn) { TR_DECODE(itn, tn); tr_load(vn, tn, lane); }
              tr_emit(vc, tc, scr, lane);
              if (hn) { tc = tn;
#pragma unroll
                  for (int i = 0; i < 16; ++i) vc[i] = vn[i]; }
              it0 = itn; } }
#undef TR_DECODE
    }
    if (a.ws == nullptr) grid.sync();
    GSYNC();
    { FRESH_IDS const float* MOD = MODP; row_phase(a.in[0], true, nullptr, false, nullptr, nullptr, nullptr, UP, (const float*)a.in[5], MOD + 1024, MOD, gw, NGW, lane); }
    GSYNC(); TS(0);

#pragma unroll 1
    for (int l = 0; l < DEPTH; ++l) {
#pragma unroll 1
        for (int half = 0; half < 2; ++half) {
            const int idx = l >> 1;
            if (half == 0) {
                if ((l & 1) == 0) {
                    if (!SKIP_HG) { pg8::EpiHgrn E{T0P, T1P, T2P, T3P, DECP, LBP + idx * D}; GEMM_PHASE(pg8::EpiHgrn, E, UP, (bf16*)WSB(W_HIN) + (size_t)idx * 4 * D * D, 4 * D, D); }
                    GSYNC(); TS(1);
                    if (!SKIP_SCAN) { FRESH_IDS hgrn_passA(L, T0P, T1P, T2P, DECP, (float*)WSB(WS_SL), (bf16*)WSB(WS_AT), (float*)WSB(WS_DP), tid, wave, lane); }
                    GSYNC();
                    if (!SKIP_SCAN) { FRESH_IDS hgrn_passB(L, T0P, T1P, T2P, T3P, DECP, (const float*)WSB(WS_SL), (const bf16*)WSB(WS_AT), (const float*)WSB(WS_DP), opqf(a.in[8]) + idx * D, UP, tid, wave, lane); }
                } else {
#pragma unroll 1
                    for (int gi = 0; gi < 3; ++gi) {
                        if (!SKIP_ROPE) { pg8::EpiRope E{T0P, (size_t)M * D, CSP, SNP}; GEMM_PHASE(pg8::EpiRope, E, UP, (bf16*)WSB(W_AIN) + (size_t)idx * 9 * D * D + (size_t)gi * 3 * D * D, 3 * D, D); }
                        GSYNC(); TS(3);
                        if (!SKIP_ATT) { FRESH_IDS attn_group(L, T0P, T1P, T2P, T3P, LSEP, 2 * gi, tid, wave, lane); }
                        if (gi < 2) { GSYNC(); TS(4); }
                    }
                }
            } else {
                if (!SKIP_SWI) { pg8::EpiSwiglu E{T0P, DFF}; GEMM_PHASE(pg8::EpiSwiglu, E, UP, (bf16*)WSB(W_FIN) + (size_t)l * 2 * DFF * D, 2 * DFF, D); }
            }
            GSYNC(); if (half == 1) TS(7); else if (l & 1) TS(4); else TS(2);
            if (!SKIP_PLAIN) {
                const bf16* Ain = (half == 1) ? T0P : ((l & 1) ? T3P : UP);
                const bf16* Bout = (half == 1) ? (bf16*)WSB(W_FOUT) + (size_t)l * DFF * D : ((l & 1) ? (bf16*)WSB(W_AOUT) + (size_t)idx * D * D : (bf16*)WSB(W_HOUT) + (size_t)idx * D * D);
                pg8::EpiPlain E{(half == 1) ? T3P : T0P, D}; GEMM_PHASE(pg8::EpiPlain, E, Ain, Bout, D, (half == 1) ? DFF : D); }
            GSYNC(); if (half == 1) TS(8); else TS(5);
            { FRESH_IDS const float* modl = MODP + (size_t)l * 8 * 6144; const float* ngl = opqf(a.in[5]) + (size_t)l * 4 * D; float* out = a.out;
              if (half == 0) row_phase((l == 0) ? a.in[0] : (const void*)out, l == 0, out, false, T0P, modl + 2 * 1024, ngl + D, UP, ngl + 2 * D, modl + 4 * 1024, modl + 3 * 1024, gw, NGW, lane);
              else row_phase(out, false, out, l == DEPTH - 1, T3P, modl + 5 * 1024, ngl + 3 * D, (l < DEPTH - 1) ? UP : nullptr, ngl + 4 * D, modl + 8 * 6144 + 1024, modl + 8 * 6144, gw, NGW, lane); }
            if (!(l == DEPTH - 1 && half == 1)) { GSYNC(); TS(6); }
        }
    }
#if PROBE
    GSYNC(); TS(6);
    for (int i_ = 0; i_ < 10; ++i_) GSYNC();
    TS(9);
    if (blockIdx.x == 0) {
        __syncthreads();
        float va_ = 0.f;
#pragma unroll
        for (int c_ = 0; c_ < 10; ++c_) if ((PROBE >> c_) & 1) va_ += *(LAS float*)(L + 144000 + 4 * c_);
        if (threadIdx.x == 0) a.out[0] += va_ * PSCALE;
    }
#endif
}

extern "C" void kernel_launch(void* const* d_in, const int* in_sizes, int n_in, void* d_out, int out_size, void* d_ws, size_t ws_size, hipStream_t stream) {
    static int grid = 0;
    if (grid == 0) {
        if (n_in != 14 || out_size != M * D || ws_size < WS_END) { fprintf(stderr, "kernel_launch: unexpected shapes (n_in %d out %d ws %zu)\n", n_in, out_size, ws_size); grid = -1; return; }
        int dev = 0, cus = 0, per_cu = 0;
        if (hipGetDevice(&dev) != hipSuccess || hipDeviceGetAttribute(&cus, hipDeviceAttributeMultiprocessorCount, dev) != hipSuccess) { grid = -1; return; }
        if (hipFuncSetAttribute((const void*)fwd_kernel, hipFuncAttributeMaxDynamicSharedMemorySize, LDS_BYTES) != hipSuccess) { fprintf(stderr, "kernel_launch: hipFuncSetAttribute failed\n"); grid = -1; return; }
        if (hipOccupancyMaxActiveBlocksPerMultiprocessor(&per_cu, (const void*)fwd_kernel, NWAVES * 64, LDS_BYTES) != hipSuccess || per_cu < 1) { fprintf(stderr, "kernel_launch: occupancy query says %d\n", per_cu); (void)hipGetLastError(); per_cu = 1; }
        grid = cus;
        if (grid != 256) { fprintf(stderr, "kernel_launch: built for 256 CUs, device has %d\n", cus); grid = -1; return; }
    }
    if (grid < 0) return;
    if (hipMemsetAsync(d_ws, 0, 16384, stream) != hipSuccess) { fprintf(stderr, "kernel_launch: memset failed\n"); return; }
    Args a{};
    for (int i = 0; i < 14; ++i) a.in[i] = d_in[i];
    a.out = (float*)d_out; a.ws = (unsigned char*)d_ws;
    void* args[] = {&a};
    hipError_t e = hipLaunchCooperativeKernel((const void*)fwd_kernel, dim3(grid), dim3(NWAVES * 64), args, LDS_BYTES, stream);
    if (e != hipSuccess) fprintf(stderr, "kernel_launch: cooperative launch failed: %s\n", hipGetErrorString(e));
}
```

```cpp
#include <hip/hip_runtime.h>
#include <hip/hip_cooperative_groups.h>
#include <cstdio>
#include <cstdint>
namespace cg = cooperative_groups;
namespace pg8 {
#define PG8_LAS __attribute__((address_space(3)))
typedef unsigned short bf16_t;
typedef short bf16x8 __attribute__((ext_vector_type(8)));
typedef float f32x4 __attribute__((ext_vector_type(4)));
typedef unsigned u32x4 __attribute__((ext_vector_type(4)));
constexpr int BM = 256, BK = 64, HALF = 128, HTB = HALF * BK * 2  , STAGE_BYTES = 8 * HTB, NXCD = 8, WGM = 8;

__host__ __device__ __forceinline__ int lds_byte(int r, int c) { const int st = (r >> 4) * 2 + (c >> 5), rr = r & 15, cc = c & 31, ob = rr * 64 + cc * 2; return st * 1024 + (ob ^ (((ob >> 9) & 1) << 5)); }
__host__ __device__ __forceinline__ void stage_rc(int b, int& R, int& C) { const int st = b / 1024, sb = b % 1024, swz = sb ^ (((sb >> 9) & 1) << 5); R = (st >> 1) * 16 + swz / 64; C = (st & 1) * 32 + (swz % 64) / 2; }
__host__ __device__ __forceinline__ int perm32(int rho) { const int n = rho >> 4, i = rho & 15; return 8 * (i >> 2) + 4 * n + (i & 3); }

struct Unit { int pm, pn; };
struct Gemm { const bf16_t* A; const bf16_t* Bt; int M, N, K; };

struct StaticOrder {
    int nM, nN, nwg, G, c;
    __host__ __device__ void init(int M, int N, int G_, int c_) { nM = M / BM; nN = N / BM; nwg = nM * nN; G = G_; c = c_; }
    __host__ __device__ bool next(int i, Unit& u) const {
        const long L = (long)i * G + c; if (L >= nwg) return false;
        int wgid = (int)L; { const int q = nwg / NXCD, r = nwg % NXCD, xcd = wgid % NXCD, off = wgid / NXCD; wgid = (xcd < r ? xcd * (q + 1) : r * (q + 1) + (xcd - r) * q) + off; }
        const int nig = WGM * nN, gid = wgid / nig, fm = gid * WGM, gsz = (nM - fm) < WGM ? (nM - fm) : WGM;
        u.pm = fm + ((wgid % nig) % gsz); u.pn = (wgid % nig) / gsz; return true;
    }
    __device__ __forceinline__ void a_ready(const Unit&) const {}
    __device__ __forceinline__ void done(const Unit&) const {}
};

#define PG8_GAS __attribute__((address_space(1)))
typedef float f32x2 __attribute__((ext_vector_type(2)));
typedef __bf16 bf16x2_t __attribute__((ext_vector_type(2)));
typedef unsigned u32x2 __attribute__((ext_vector_type(2)));
__device__ __forceinline__ unsigned cvt_pk_bf16(float lo, float hi) { unsigned r; asm volatile("v_cvt_pk_bf16_f32 %0, %1, %2" : "=v"(r) : "v"(lo), "v"(hi)); return r; }
__device__ __forceinline__ unsigned cvt_pk_bf16_c(float lo, float hi) { f32x2 v = {lo, hi}; bf16x2_t b = __builtin_convertvector(v, bf16x2_t); return __builtin_bit_cast(unsigned, b); }
__device__ __forceinline__ float silu_f(float x) { return x * __builtin_amdgcn_rcpf(1.0f + __expf(-x)); }
__device__ __forceinline__ u32x4 pack8(const f32x4& a, const f32x4& b) { u32x4 w; w.x = cvt_pk_bf16(a[0], a[1]); w.y = cvt_pk_bf16(a[2], a[3]); w.z = cvt_pk_bf16(b[0], b[1]); w.w = cvt_pk_bf16(b[2], b[3]); return w; }
__device__ __forceinline__ u32x2 pack4(const f32x4& a) { u32x2 w; w.x = cvt_pk_bf16(a[0], a[1]); w.y = cvt_pk_bf16(a[2], a[3]); return w; }
__device__ __forceinline__ u32x4 pack8_c(const f32x4& a, const f32x4& b) { u32x4 w; w.x = cvt_pk_bf16_c(a[0], a[1]); w.y = cvt_pk_bf16_c(a[2], a[3]); w.z = cvt_pk_bf16_c(b[0], b[1]); w.w = cvt_pk_bf16_c(b[2], b[3]); return w; }
__device__ __forceinline__ u32x2 pack4_c(const f32x4& a) { u32x2 w; w.x = cvt_pk_bf16_c(a[0], a[1]); w.y = cvt_pk_bf16_c(a[2], a[3]); return w; }

struct EpiPlain {
    static constexpr bool PERM = true, AFTER_DRAIN = false;
    bf16_t* O; int ldc;
    __device__ __forceinline__ void operator()(const f32x4 (&acc)[2][2][4][2], const Unit& u, int wr, int wc, int fr, int fq) const {
        const int row0 = u.pm * BM + wr * 64 + fr, col0 = u.pn * BM + wc * 32 + 8 * fq;
#pragma unroll
        for (int ai = 0; ai < 2; ++ai)
#pragma unroll
            for (int m = 0; m < 4; ++m) { bf16_t* rowp = O + (size_t)(row0 + ai * HALF + m * 16) * ldc + col0;
#pragma unroll
                for (int bj = 0; bj < 2; ++bj) *(PG8_GAS u32x4*)(rowp + bj * HALF) = pack8(acc[ai][bj][m][0], acc[ai][bj][m][1]); }
    }
};
struct EpiSwiglu {
    static constexpr bool PERM = true, AFTER_DRAIN = false;
    bf16_t* H; int ldc;
    __device__ __forceinline__ void operator()(const f32x4 (&acc)[2][2][4][2], const Unit& u, int wr, int wc, int fr, int fq) const {
        const int row0 = u.pm * BM + wr * 64 + fr, col0 = u.pn * HALF + wc * 32 + 8 * fq;
#pragma unroll
        for (int ai = 0; ai < 2; ++ai)
#pragma unroll
            for (int m = 0; m < 4; ++m) { f32x4 r0, r1;
#pragma unroll
                for (int i = 0; i < 4; ++i) { r0[i] = silu_f(acc[ai][0][m][0][i]) * acc[ai][1][m][0][i]; r1[i] = silu_f(acc[ai][0][m][1][i]) * acc[ai][1][m][1][i]; }
                *(PG8_GAS u32x4*)(H + (size_t)(row0 + ai * HALF + m * 16) * ldc + col0) = pack8(r0, r1); }
    }
};
struct EpiRope {
    static constexpr bool PERM = true, AFTER_DRAIN = false;
    bf16_t* QKV; size_t tstride; const float* cs; const float* sn;
    __device__ __forceinline__ void operator()(const f32x4 (&acc)[2][2][4][2], const Unit& u, int wr, int wc, int fr, int fq) const {
        const int t = u.pn >> 2; bf16_t* base = QKV + (size_t)t * tstride;
        const int row0 = u.pm * BM + wr * 64 + fr, col0 = (u.pn & 3) * BM + wc * 32 + 8 * fq;
        const bool rope = (t < 2) && (wc == 0); const float scale = (t == 0) ? 0.08838834764831845f : 1.0f;
        const float sgn = (fq < 2) ? -1.0f : 1.0f;
#pragma unroll
        for (int ai = 0; ai < 2; ++ai)
#pragma unroll
            for (int m = 0; m < 4; ++m) { const int row = row0 + ai * HALF + m * 16;
                f32x4 c0 = {1.f, 1.f, 1.f, 1.f}, c1 = c0, s0 = {0.f, 0.f, 0.f, 0.f}, s1 = s0;
                if (rope) { const float* cp = cs + (size_t)row * 16 + 8 * (fq & 1); const float* sp = sn + (size_t)row * 16 + 8 * (fq & 1);
                    c0 = *(const PG8_GAS f32x4*)cp; c1 = *(const PG8_GAS f32x4*)(cp + 4); s0 = *(const PG8_GAS f32x4*)sp * sgn; s1 = *(const PG8_GAS f32x4*)(sp + 4) * sgn; }
#pragma unroll
                for (int bj = 0; bj < 2; ++bj) { f32x4 v0 = acc[ai][bj][m][0], v1 = acc[ai][bj][m][1];
                    if (rope) { f32x4 p0, p1;
#pragma unroll
                        for (int i = 0; i < 4; ++i) { p0[i] = __shfl_xor(v0[i], 32); p1[i] = __shfl_xor(v1[i], 32); }
                        v0 = v0 * c0 + p0 * s0; v1 = v1 * c1 + p1 * s1; }
                    v0 = v0 * scale; v1 = v1 * scale;
                    *(PG8_GAS u32x4*)(base + (size_t)row * 1024 + col0 + bj * HALF) = pack8(v0, v1); } }
    }
};
#define DPP_SHR(x, n) __builtin_bit_cast(float, __builtin_amdgcn_update_dpp(0, __builtin_bit_cast(int, (x)), 0x110 + (n), 0xf, 0xf, false))
__device__ __forceinline__ float row_scan16(float x) { x += DPP_SHR(x, 1); x += DPP_SHR(x, 2); x += DPP_SHR(x, 4); x += DPP_SHR(x, 8); return x; }
#define DPP_SHR1(x, n) __builtin_bit_cast(float, __builtin_amdgcn_update_dpp(0x3f800000, __builtin_bit_cast(int, (x)), 0x110 + (n), 0xf, 0xf, false))
__device__ __forceinline__ float row_scanmul16(float x) { x *= DPP_SHR1(x, 1); x *= DPP_SHR1(x, 2); x *= DPP_SHR1(x, 4); x *= DPP_SHR1(x, 8); return x; }
struct EpiHgrn {
    static constexpr bool PERM = true, AFTER_DRAIN = false;
    bf16_t *QD, *KI, *VV, *GG; float* DEC; const float* lb;
    __device__ __forceinline__ void operator()(const f32x4 (&acc)[2][2][4][2], const Unit& u, int wr, int wc, int fr, int fq) const {
        const int row0 = u.pm * BM + wr * 64 + fr;
        if (u.pn >= 8) {
            bf16_t* base = (u.pn >= 12) ? GG : VV; const int col0 = (u.pn & 3) * BM + wc * 32 + 8 * fq;
#pragma unroll
            for (int ai = 0; ai < 2; ++ai)
#pragma unroll
                for (int m = 0; m < 4; ++m) { bf16_t* rowp = base + (size_t)(row0 + ai * HALF + m * 16) * 1024 + col0;
#pragma unroll
                    for (int bj = 0; bj < 2; ++bj) { f32x4 v0 = acc[ai][bj][m][0], v1 = acc[ai][bj][m][1];
                        if (u.pn >= 12) {
#pragma unroll
                            for (int i = 0; i < 4; ++i) { v0[i] = silu_f(v0[i]); v1[i] = silu_f(v1[i]); } }
                        *(PG8_GAS u32x4*)(rowp + bj * HALF) = pack8(v0, v1); } }
            return;
        }
        const int col0 = u.pn * HALF + wc * 32 + 8 * fq;
        const f32x4 lb0 = *(const PG8_GAS f32x4*)(lb + col0), lb1 = *(const PG8_GAS f32x4*)(lb + col0 + 4);
        const int lane15 = (threadIdx.x & 48) | 15;
#pragma unroll
        for (int ai = 0; ai < 2; ++ai)
#pragma unroll
            for (int mp = 0; mp < 2; ++mp) {
                const int ra = row0 + ai * HALF + mp * 32, rb = ra + 16;
                f32x4 qa[2], qb[2], ka[2], kb[2], dc[2];
#pragma unroll
                for (int n = 0; n < 2; ++n)
#pragma unroll
                    for (int i = 0; i < 4; ++i) {
                        const float lbv = n ? lb1[i] : lb0[i], oml = 1.0f - lbv;
                        const float fa = acc[ai][1][2 * mp][n][i], fb = acc[ai][1][2 * mp + 1][n][i];
                        const float ta = __expf(-fabsf(fa)), ra_ = __builtin_amdgcn_rcpf(1.0f + ta), sa = fa >= 0.f ? ra_ : ta * ra_, na = fa >= 0.f ? ta * ra_ : ra_;
                        const float tb = __expf(-fabsf(fb)), rb_ = __builtin_amdgcn_rcpf(1.0f + tb), sb = fb >= 0.f ? rb_ : tb * rb_, nb = fb >= 0.f ? tb * rb_ : rb_;
                        const float ca = row_scanmul16(lbv + oml * sa), cb0 = row_scanmul16(lbv + oml * sb);
                        const float tota = __shfl(ca, lane15), totb = __shfl(cb0, lane15);
                        const float pa = ca, pb = tota * cb0;
                        qa[n][i] = silu_f(acc[ai][0][2 * mp][n][i]) * pa; qb[n][i] = silu_f(acc[ai][0][2 * mp + 1][n][i]) * pb;
                        ka[n][i] = oml * na * __builtin_amdgcn_rcpf(pa); kb[n][i] = oml * nb * __builtin_amdgcn_rcpf(pb); dc[n][i] = tota * totb;
                    }
                *(PG8_GAS u32x4*)(QD + (size_t)ra * 1024 + col0) = pack8(qa[0], qa[1]); *(PG8_GAS u32x4*)(QD + (size_t)rb * 1024 + col0) = pack8(qb[0], qb[1]);
                *(PG8_GAS u32x4*)(KI + (size_t)ra * 1024 + col0) = pack8(ka[0], ka[1]); *(PG8_GAS u32x4*)(KI + (size_t)rb * 1024 + col0) = pack8(kb[0], kb[1]);
                if (fr == 0) { float* dp = DEC + (size_t)(ra >> 5) * 1024 + col0; *(PG8_GAS f32x4*)dp = dc[0]; *(PG8_GAS f32x4*)(dp + 4) = dc[1]; }
            }
    }
};

template <class Epi, class Sched, bool ALIGN_EPI = false, bool SP2 = false>
__device__ __forceinline__ void gemm_phase(PG8_LAS unsigned char* lds, const Gemm g, const Sched& S, const Epi& E) {
    int tid_o = threadIdx.x; asm volatile("" : "+v"(tid_o)); const int tid = tid_o, wid = __builtin_amdgcn_readfirstlane(tid >> 6), lane = tid & 63, wr = wid >> 2, wc = wid & 3, fr = lane & 15, fq = lane >> 4;
    const int K = g.K, nt = K / BK;
    unsigned voffA[2], voffB[2];
#pragma unroll
    for (int i = 0; i < 2; ++i) { int R, C; stage_rc(tid * 16 + i * 8192, R, C); const int Rb = Epi::PERM ? ((R & ~31) + perm32(R & 31)) : R;
        voffA[i] = (unsigned)(R * K + C) * 2u; voffB[i] = (unsigned)(Rb * K + C) * 2u; }
    const size_t kstep = (size_t)(BK * 2);
    const size_t hstep = (size_t)HALF * K * 2;
    const size_t tstep = 2 * hstep;
    const unsigned ldsw = (unsigned)wid * 1024u;
    const int aoff = lds_byte(wr * 64 + fr, fq * 8), boff = lds_byte(wc * 32 + fr, fq * 8);
#define PG8_SA(b, h) (((b) * 2 + (h)) * HTB)
#define PG8_SB(b, h) ((4 + (b) * 2 + (h)) * HTB)
#define PG8_STAGE(bufoff, gbase, voff) do { _Pragma("unroll") for (int _i = 0; _i < 2; ++_i) \
        __builtin_amdgcn_global_load_lds((const unsigned*)((const char*)(gbase) + (voff)[_i]), (PG8_LAS unsigned*)(lds + (bufoff) + ldsw + _i * 8192), 16, 0, 0); } while (0)
#define PG8_LDA(dst, b, h) do { _Pragma("unroll") for (int m = 0; m < 4; ++m) _Pragma("unroll") for (int k = 0; k < 2; ++k) dst[m][k] = *(const PG8_LAS bf16x8*)(lds + PG8_SA(b, h) + aoff + m * 2048 + k * 1024); } while (0)
#define PG8_LDB(dst, b, h) do { _Pragma("unroll") for (int n = 0; n < 2; ++n) _Pragma("unroll") for (int k = 0; k < 2; ++k) dst[n][k] = *(const PG8_LAS bf16x8*)(lds + PG8_SB(b, h) + boff + n * 2048 + k * 1024); } while (0)
#define PG8_MMA(ai, bj, At, Bt) do { __builtin_amdgcn_s_setprio(1); _Pragma("unroll") for (int m = 0; m < 4; ++m) _Pragma("unroll") for (int n = 0; n < 2; ++n) _Pragma("unroll") for (int k = 0; k < 2; ++k) \
        acc[ai][bj][m][n] = __builtin_amdgcn_mfma_f32_16x16x32_bf16(Bt[n][k], At[m][k], acc[ai][bj][m][n], 0, 0, 0); __builtin_amdgcn_s_setprio(0); } while (0)
#define PG8_WAIT_V(n) asm volatile("s_waitcnt vmcnt(" #n ")" ::: "memory")
#define PG8_WAIT_L(n) asm volatile("s_waitcnt lgkmcnt(" #n ")" ::: "memory")
#define PG8_BAR __builtin_amdgcn_s_barrier()
#define PG8_SCHED __builtin_amdgcn_sched_barrier(0)
    Unit cur, nxt; int ui = 0;
    if (!S.next(0, cur)) return;
    f32x4 acc[2][2][4][2];
#pragma unroll
    for (int a = 0; a < 2; ++a)
#pragma unroll
        for (int b = 0; b < 2; ++b)
#pragma unroll
            for (int m = 0; m < 4; ++m)
#pragma unroll
                for (int n = 0; n < 2; ++n) acc[a][b][m][n] = (f32x4){0.f, 0.f, 0.f, 0.f};
    bf16x8 At[4][2], B0[2][2], B1[2][2];
    const char* cA = (const char*)g.A + (size_t)cur.pm * tstep; const char* cB = (const char*)g.Bt + (size_t)cur.pn * tstep;
    S.a_ready(cur);
    if constexpr (SP2) {
        PG8_STAGE(PG8_SB(0, 0), cB, voffB); PG8_STAGE(PG8_SB(0, 1), cB + hstep, voffB); PG8_STAGE(PG8_SA(0, 0), cA, voffA); PG8_STAGE(PG8_SA(0, 1), cA + hstep, voffA);
        if (wr == 1) PG8_BAR;
        PG8_WAIT_V(2); PG8_BAR;
        PG8_STAGE(PG8_SB(1, 0), cB + kstep, voffB); PG8_STAGE(PG8_SA(1, 0), cA + kstep, voffA); PG8_STAGE(PG8_SB(1, 1), cB + hstep + kstep, voffB);
        PG8_WAIT_V(6); PG8_BAR;
    } else {
        PG8_STAGE(PG8_SB(0, 0), cB, voffB); PG8_STAGE(PG8_SA(0, 0), cA, voffA); PG8_STAGE(PG8_SB(0, 1), cB + hstep, voffB); PG8_STAGE(PG8_SA(0, 1), cA + hstep, voffA);
        if (wr == 1) PG8_BAR;
        PG8_WAIT_V(4); PG8_BAR;
        PG8_STAGE(PG8_SB(1, 0), cB + kstep, voffB); PG8_STAGE(PG8_SA(1, 0), cA + kstep, voffA); PG8_STAGE(PG8_SB(1, 1), cB + hstep + kstep, voffB);
        PG8_WAIT_V(6); PG8_BAR;
    }
    for (;;) {
        const bool has_next = S.next(ui + 1, nxt);
        const char* nA = has_next ? (const char*)g.A + (size_t)nxt.pm * tstep : cA; const char* nB = has_next ? (const char*)g.Bt + (size_t)nxt.pn * tstep : cB;
        for (int t = 0; t < nt; t += 2) {
            const bool last = (t == nt - 2);
            const char* a1 = cA + (size_t)(t + 1) * kstep;
            const char* a2 = last ? nA : cA + (size_t)(t + 2) * kstep; const char* b2 = last ? nB : cB + (size_t)(t + 2) * kstep;
            const char* a3 = a2 + kstep; const char* b3 = b2 + kstep;
            if (last && has_next) S.a_ready(nxt);
            if constexpr (SP2) {
            PG8_LDB(B0, 0, 0); PG8_LDB(B1, 0, 1); PG8_SCHED; PG8_LDA(At, 0, 0); PG8_STAGE(PG8_SA(1, 1), a1 + hstep, voffA);
            PG8_WAIT_V(8); PG8_WAIT_L(0); PG8_BAR; PG8_MMA(0, 0, At, B0); PG8_MMA(0, 1, At, B1); PG8_BAR; PG8_SCHED;
            PG8_LDA(At, 0, 1); PG8_STAGE(PG8_SB(0, 0), b2, voffB); PG8_STAGE(PG8_SB(0, 1), b2 + hstep, voffB); PG8_STAGE(PG8_SA(0, 0), a2, voffA);
            PG8_WAIT_V(8); PG8_WAIT_L(0); PG8_BAR; PG8_MMA(1, 0, At, B0); PG8_MMA(1, 1, At, B1); PG8_BAR; PG8_SCHED;
            PG8_LDB(B0, 1, 0); PG8_LDB(B1, 1, 1); PG8_SCHED; PG8_LDA(At, 1, 0); PG8_STAGE(PG8_SA(0, 1), a2 + hstep, voffA);
            PG8_WAIT_V(8); PG8_WAIT_L(0); PG8_BAR; PG8_MMA(0, 0, At, B0); PG8_MMA(0, 1, At, B1); PG8_BAR; PG8_SCHED;
            PG8_LDA(At, 1, 1); PG8_STAGE(PG8_SB(1, 0), b3, voffB); PG8_STAGE(PG8_SB(1, 1), b3 + hstep, voffB); PG8_STAGE(PG8_SA(1, 0), a3, voffA);
            PG8_WAIT_V(8); PG8_WAIT_L(0); PG8_BAR; PG8_MMA(1, 0, At, B0); PG8_MMA(1, 1, At, B1); PG8_BAR; PG8_SCHED;
            } else {
            PG8_LDB(B0, 0, 0); PG8_SCHED; PG8_LDA(At, 0, 0); PG8_STAGE(PG8_SA(1, 1), a1 + hstep, voffA);
            PG8_WAIT_L(8); PG8_BAR; PG8_WAIT_L(0); PG8_MMA(0, 0, At, B0); PG8_BAR; PG8_SCHED;
            PG8_LDB(B1, 0, 1); PG8_STAGE(PG8_SB(0, 0), b2, voffB);
            PG8_BAR; PG8_WAIT_L(0); PG8_MMA(0, 1, At, B1); PG8_BAR;
            PG8_LDA(At, 0, 1); PG8_STAGE(PG8_SA(0, 0), a2, voffA);
            PG8_BAR; PG8_WAIT_L(0); PG8_MMA(1, 0, At, B0); PG8_BAR; PG8_SCHED;
            PG8_STAGE(PG8_SB(0, 1), b2 + hstep, voffB);
            PG8_WAIT_V(6); PG8_BAR; PG8_MMA(1, 1, At, B1); PG8_BAR;
            PG8_LDB(B0, 1, 0); PG8_SCHED; PG8_LDA(At, 1, 0); PG8_STAGE(PG8_SA(0, 1), a2 + hstep, voffA);
            PG8_WAIT_L(8); PG8_BAR; PG8_WAIT_L(0); PG8_MMA(0, 0, At, B0); PG8_BAR; PG8_SCHED;
            PG8_LDB(B1, 1, 1); PG8_STAGE(PG8_SB(1, 0), b3, voffB);
            PG8_BAR; PG8_WAIT_L(0); PG8_MMA(0, 1, At, B1); PG8_BAR;
            PG8_LDA(At, 1, 1); PG8_STAGE(PG8_SA(1, 0), a3, voffA);
            PG8_BAR; PG8_WAIT_L(0); PG8_MMA(1, 0, At, B0); PG8_BAR; PG8_SCHED;
            PG8_STAGE(PG8_SB(1, 1), b3 + hstep, voffB);
            PG8_WAIT_V(6); PG8_BAR; PG8_MMA(1, 1, At, B1); PG8_BAR;
            }
        }
        if constexpr (ALIGN_EPI) { if (wr == 0) PG8_BAR; }
        if constexpr (!Epi::AFTER_DRAIN) { E(acc, cur, wr, wc, fr, fq); S.done(cur); }
        if (!has_next) break;
#pragma unroll
        for (int a = 0; a < 2; ++a)
#pragma unroll
            for (int b = 0; b < 2; ++b)
#pragma unroll
                for (int m = 0; m < 4; ++m)
#pragma unroll
                    for (int n = 0; n < 2; ++n) acc[a][b][m][n] = (f32x4){0.f, 0.f, 0.f, 0.f};
        cur = nxt; cA = nA; cB = nB; ++ui;
        if constexpr (ALIGN_EPI) { if (wr == 1) PG8_BAR; }
    }
    PG8_WAIT_V(0);
    if constexpr (!ALIGN_EPI) { if (wr == 0) PG8_BAR; }
    PG8_BAR;
    if constexpr (Epi::AFTER_DRAIN) { E.fused(acc, cur, wr, wc, fr, fq, lds, wid, lane); S.done(cur); }
#undef PG8_SA
#undef PG8_SB
#undef PG8_STAGE
#undef PG8_LDA
#undef PG8_LDB
#undef PG8_MMA
#undef PG8_WAIT_V
#undef PG8_WAIT_L
#undef PG8_BAR
#undef PG8_SCHED
}
}

#define LAS __attribute__((address_space(3)))
#define GAS __attribute__((address_space(1)))
typedef unsigned short bf16;
typedef unsigned v4u __attribute__((ext_vector_type(4)));
typedef unsigned v2u __attribute__((ext_vector_type(2)));
typedef float f32x4 __attribute__((ext_vector_type(4)));
typedef short bf16x8 __attribute__((ext_vector_type(8)));
typedef short s16x4 __attribute__((ext_vector_type(4)));
typedef short v4i16_t __attribute__((ext_vector_type(4)));
constexpr int BATCH = 8, SEQ = 4096, D = 1024, M = BATCH * SEQ, DFF = 2816, NH = 8, HD = 128, DEPTH = 4;
constexpr float EPS = 1e-6f;
constexpr size_t MiB = 1u << 20;
constexpr size_t WS_MOD = 1 * MiB;
constexpr size_t WS_LB = WS_MOD + 4 * 8 * 6144 * 4;
constexpr size_t WS_ROPE = 2 * MiB;
constexpr size_t WS_LSE = 6 * MiB;
constexpr size_t WS_W = 8 * MiB;
constexpr size_t W_HIN = WS_W, W_HOUT = WS_W + 16 * MiB, W_AIN = WS_W + 20 * MiB, W_AOUT = WS_W + 56 * MiB, W_FIN = WS_W + 60 * MiB, W_FOUT = WS_W + 104 * MiB;
constexpr size_t WS_U = 134 * MiB;
constexpr size_t WS_R = 198 * MiB;
constexpr size_t WS_SL = 458 * MiB;
constexpr size_t WS_AT = 472 * MiB;
constexpr size_t WS_DP = 490 * MiB;
constexpr size_t WS_END = 491 * MiB;
constexpr int LDS_BYTES = 147456;
constexpr int NWAVES = 8;

__device__ __forceinline__ unsigned pk2(float lo, float hi) { return pg8::cvt_pk_bf16_c(lo, hi); }
__device__ __forceinline__ float bflo(unsigned w) { return __builtin_bit_cast(float, w << 16); }
__device__ __forceinline__ float bfhi(unsigned w) { return __builtin_bit_cast(float, w & 0xffff0000u); }
__device__ __forceinline__ float wave_sum(float v) {
#pragma unroll
    for (int o = 1; o < 64; o <<= 1) v += __shfl_xor(v, o);
    return v;
}
#define MFMA16(a, b, c) __builtin_amdgcn_mfma_f32_16x16x32_bf16((a), (b), (c), 0, 0, 0)
__device__ __forceinline__ s16x4 tr_read(LAS const unsigned char* p) { return __builtin_bit_cast(s16x4, __builtin_amdgcn_ds_read_tr16_b64_v4i16((LAS v4i16_t*)p)); }
__device__ __forceinline__ bf16x8 cat4(s16x4 a, s16x4 b) { return __builtin_shufflevector(a, b, 0, 1, 2, 3, 4, 5, 6, 7); }
__device__ __forceinline__ bf16x8 pack_f8(const f32x4& a, const f32x4& b) { v4u w = pg8::pack8_c(a, b); return __builtin_bit_cast(bf16x8, w); }

__device__ __forceinline__ void transpose_item(const float* W, int K, int N, bf16* WT, int k0, int n0, int drow0, LAS float* scr, int lane) {
    const int lr = lane >> 4, lc = lane & 15;
    f32x4 v[16];
#pragma unroll
    for (int i = 0; i < 16; ++i) v[i] = *(const GAS f32x4*)(W + (size_t)(k0 + 4 * i + lr) * N + n0 + 4 * lc);
#pragma unroll
    for (int i = 0; i < 16; ++i) { LAS float* d = scr + (4 * i + lr) * 65 + 4 * lc; d[0] = v[i][0]; d[1] = v[i][1]; d[2] = v[i][2]; d[3] = v[i][3]; }
    asm volatile("s_waitcnt lgkmcnt(0)" ::: "memory");
    const int c = lane & 7;
#pragma unroll
    for (int j = 0; j < 8; ++j) { const int n = (lane >> 3) + 8 * j; const LAS float* s = scr + (8 * c) * 65 + n;
        v4u o; o.x = pk2(s[0 * 65], s[1 * 65]); o.y = pk2(s[2 * 65], s[3 * 65]); o.z = pk2(s[4 * 65], s[5 * 65]); o.w = pk2(s[6 * 65], s[7 * 65]);
        *(GAS v4u*)(WT + (size_t)(drow0 + n) * K + k0 + 8 * c) = o; }
    asm volatile("s_waitcnt lgkmcnt(0)" ::: "memory");
}
__device__ __forceinline__ bool transpose_family(int& it, const float* W, int cnt, int K, int N, bf16* dst, size_t dstride, int mode, LAS float* scr, int lane) {
    const int nblk = N / 64, per = (K / 64) * nblk, tot = cnt * per;
    if (it >= tot) { it -= tot; return false; }
    const int mi = it / per, r = it % per, kb = r / nblk, nb = r % nblk, n0 = nb * 64; int drow = n0;
    if (mode == 1) { if (n0 < 2048) drow = 256 * ((n0 & 1023) >> 7) + 128 * (n0 >> 10) + (n0 & 127); }
    else if (mode == 2) { const int half = n0 >= DFF ? 1 : 0, jj = n0 - half * DFF; drow = 256 * (jj >> 7) + 128 * half + (jj & 127); }
    transpose_item(W + (size_t)mi * K * N, K, N, dst + (size_t)mi * dstride, kb * 64, n0, drow, scr, lane);
    return true;
}

struct RowRegs { f32x4 h[4]; v4u hb[2]; v4u y[2]; };
__device__ __forceinline__ void row_load(RowRegs& r, const void* hin, bool hin_f32, const bf16* Y, size_t row, int lane) {
#pragma unroll
    for (int j = 0; j < 2; ++j) {
        if (hin_f32) { const float* hp = (const float*)hin + row * D + 8 * lane + 512 * j; r.h[2 * j] = *(const GAS f32x4*)hp; r.h[2 * j + 1] = *(const GAS f32x4*)(hp + 4); }
        else r.hb[j] = *(const GAS v4u*)((const bf16*)hin + row * 2048 + 8 * lane + 512 * j);
        if (Y) r.y[j] = *(const GAS v4u*)(Y + row * D + 8 * lane + 512 * j); }
}
__device__ __forceinline__ void row_phase(const void* hin, bool hin_f32, void* hout, bool hout_f32, const bf16* Y, const float* gate, const float* ngy,
                                          bf16* U, const float* ngu, const float* sc, const float* sh, int gw, int NGW, int lane) {
    const int b = gw >> 8; const size_t row0 = (size_t)b * SEQ + (size_t)(gw & 255) * 16;
    float ysc[16], usc[16], ush[16];
#pragma unroll
    for (int j = 0; j < 2; ++j)
#pragma unroll
        for (int q = 0; q < 2; ++q) { const int col = 8 * lane + 512 * j + 4 * q;
            if (Y) { const f32x4 gt = *(const GAS f32x4*)(gate + (size_t)b * 6144 + col), ng = *(const GAS f32x4*)(ngy + col);
#pragma unroll
                for (int e = 0; e < 4; ++e) ysc[8 * j + 4 * q + e] = (1.0f + gt[e]) * ng[e]; }
            if (U) { const f32x4 ng = *(const GAS f32x4*)(ngu + col), s1 = *(const GAS f32x4*)(sc + (size_t)b * 6144 + col), s0 = *(const GAS f32x4*)(sh + (size_t)b * 6144 + col);
#pragma unroll
                for (int e = 0; e < 4; ++e) { usc[8 * j + 4 * q + e] = ng[e] * (1.0f + s1[e]); ush[8 * j + 4 * q + e] = s0[e]; } } }
    RowRegs cur, nxt, nx2;
    row_load(cur, hin, hin_f32, Y, row0, lane); row_load(nxt, hin, hin_f32, Y, row0 + 1, lane);
#pragma unroll
    for (int k = 0; k < 16; ++k) {
        const size_t row = row0 + k;
        if (k + 2 < 16) row_load(nx2, hin, hin_f32, Y, row + 2, lane);
        float hv[16];
#pragma unroll
        for (int j = 0; j < 2; ++j)
#pragma unroll
            for (int e = 0; e < 4; ++e) {
                if (hin_f32) { hv[8 * j + e] = cur.h[2 * j][e]; hv[8 * j + 4 + e] = cur.h[2 * j + 1][e]; }
                else { hv[8 * j + 2 * e] = bflo(cur.hb[j][e]); hv[8 * j + 2 * e + 1] = bfhi(cur.hb[j][e]); } }
        if (Y) {
            float yv[16]; float ss = 0.f;
#pragma unroll
            for (int j = 0; j < 2; ++j)
#pragma unroll
                for (int e = 0; e < 4; ++e) { yv[8 * j + 2 * e] = bflo(cur.y[j][e]); yv[8 * j + 2 * e + 1] = bfhi(cur.y[j][e]); }
#pragma unroll
            for (int e = 0; e < 16; ++e) ss += yv[e] * yv[e];
            const float rstd = __builtin_amdgcn_rsqf(wave_sum(ss) * (1.0f / D) + EPS);
#pragma unroll
            for (int e = 0; e < 16; ++e) hv[e] += ysc[e] * (yv[e] * rstd);
#pragma unroll
            for (int j = 0; j < 2; ++j) {
                if (hout_f32) { float* op = (float*)hout + row * D + 8 * lane + 512 * j;
                    *(GAS f32x4*)op = (f32x4){hv[8 * j], hv[8 * j + 1], hv[8 * j + 2], hv[8 * j + 3]}; *(GAS f32x4*)(op + 4) = (f32x4){hv[8 * j + 4], hv[8 * j + 5], hv[8 * j + 6], hv[8 * j + 7]}; }
                else { v4u w; w.x = pk2(hv[8 * j], hv[8 * j + 1]); w.y = pk2(hv[8 * j + 2], hv[8 * j + 3]); w.z = pk2(hv[8 * j + 4], hv[8 * j + 5]); w.w = pk2(hv[8 * j + 6], hv[8 * j + 7]);
                    *(GAS v4u*)((bf16*)hout + row * 2048 + 8 * lane + 512 * j) = w;
#pragma unroll
                    for (int e = 0; e < 4; ++e) { hv[8 * j + 2 * e] = bflo(w[e]); hv[8 * j + 2 * e + 1] = bfhi(w[e]); } }
            }
        }
        if (U) {
            float ss = 0.f;
#pragma unroll
            for (int e = 0; e < 16; ++e) ss += hv[e] * hv[e];
            const float rstd = __builtin_amdgcn_rsqf(wave_sum(ss) * (1.0f / D) + EPS);
#pragma unroll
            for (int j = 0; j < 2; ++j) { float uv[8];
#pragma unroll
                for (int e = 0; e < 8; ++e) uv[e] = hv[8 * j + e] * rstd * usc[8 * j + e] + ush[8 * j + e];
                v4u w; w.x = pk2(uv[0], uv[1]); w.y = pk2(uv[2], uv[3]); w.z = pk2(uv[4], uv[5]); w.w = pk2(uv[6], uv[7]);
                *(GAS v4u*)(U + row * D + 8 * lane + 512 * j) = w; }
        }
        cur = nxt; nxt = nx2;
    }
}

struct ScanSet { v4u q, k, v; f32x4 d; };
struct ScanAux { v2u g0, g1; };
#define GLD(T, base, off) (*(const GAS T*)((const GAS char*)(base) + (unsigned)(off)))
#define GST(T, base, off) (*(GAS T*)((GAS char*)(base) + (unsigned)(off)))
template <bool WQ>
__device__ __forceinline__ void scan_load(ScanSet& s, const bf16* QD, const bf16* KI, const bf16* VV, const float* DEC, unsigned offq, unsigned offd, int c, int cend, int tid) {
    if (c < cend) { const unsigned o = offq + (unsigned)c * 65536u; if (WQ) s.q = GLD(v4u, QD, o); s.k = GLD(v4u, KI, o); s.v = GLD(v4u, VV, o);
        if (tid < 32) s.d = GLD(f32x4, DEC, offd + (unsigned)c * 4096u); }
}
__device__ __forceinline__ void aux_load(ScanAux& s, const bf16* GG, const bf16* AT, unsigned offg, unsigned offa, int c, int cend) {
    if (c < cend) { const unsigned o = offg + (unsigned)c * 65536u; s.g0 = GLD(v2u, GG, o); s.g1 = GLD(v2u, GG, o + 32768u);
                    }
}
template <bool WQ>
__device__ __forceinline__ void scan_store(const ScanSet& s, LAS unsigned char* B, int lrow, int lch, int tid) {
    constexpr int PITCH = 288, TB = 32 * PITCH, DOFF = 3 * TB;
    LAS unsigned char* d = B + lrow * PITCH + lch * 16; if (WQ) *(LAS v4u*)(B + lrow * 272 + lch * 16) = s.q; *(LAS v4u*)(d + TB) = s.k; *(LAS v4u*)(d + 2 * TB) = s.v; if (tid < 32) *(LAS f32x4*)(B + DOFF + tid * 16) = s.d;
}
#define SCAN_UPDATE(B0, VB) do { \
          _Pragma("unroll") for (int kt = 0; kt < 8; ++kt) { LAS const unsigned char* pkk = (B0) + TB + (4 * g + q4) * PITCH + (16 * kt + 4 * p4) * 2; const bf16x8 kf = cat4(tr_read(pkk), tr_read(pkk + 16 * PITCH)); \
              S[kt] = MFMA16(kf, VB, S[kt]); const f32x4 dv = *(LAS const f32x4*)((B0) + DOFF + (16 * kt + 4 * g) * 4); S[kt] = S[kt] * dv; } } while (0)
#define SCAN_VFRAG(B0) cat4(tr_read((B0) + 2 * TB + (4 * g + q4) * PITCH + (16 * wave + 4 * p4) * 2), tr_read((B0) + 2 * TB + (20 * 1 + 4 * g + q4 - 4) * PITCH + (16 * wave + 4 * p4) * 2))
__device__ __forceinline__ void hgrn_passA(LAS unsigned char* L, const bf16* QD, const bf16* KI, const bf16* VV, const float* DEC, float* SL, bf16* AT, float* DP, int tid, int wave, int lane) {
    constexpr int PITCH = 288, TB = 32 * PITCH, BUF = 28672, DOFF = 3 * TB;
    const int bh = blockIdx.x >> 2, seg = blockIdx.x & 3, b = bh >> 3, h = bh & 7, fr = lane & 15, g = lane >> 4, q4 = fr >> 2, p4 = fr & 3;
    const unsigned rowbase = (unsigned)b * SEQ * D + h * HD;
    const int lrow = tid >> 4, lch = tid & 15, c0 = seg * 32, cend = c0 + 32;
    const unsigned offq = (rowbase + lrow * D + lch * 8) * 2u, offd = ((unsigned)(b * 128) * D + h * HD + tid * 4) * 4u, offa = ((unsigned)(bh * 128) * 64 + lane) * 32u;
    if (seg == 3) return;
    if (tid < 128) { float p = 1.0f;
#pragma unroll 8
        for (int i = 0; i < 32; ++i) p *= *(const GAS float*)(DEC + (size_t)(b * 128 + c0 + i) * D + h * HD + tid);
        *(GAS float*)(DP + (size_t)(bh * 3 + seg) * 128 + tid) = p; }
    f32x4 S[8];
#pragma unroll
    for (int i = 0; i < 8; ++i) S[i] = (f32x4){0.f, 0.f, 0.f, 0.f};
    ScanSet s0, s1, s2, s3;
    scan_load<false>(s0, QD, KI, VV, DEC, offq, offd, c0, cend, tid); scan_load<false>(s1, QD, KI, VV, DEC, offq, offd, c0 + 1, cend, tid);
    scan_load<false>(s2, QD, KI, VV, DEC, offq, offd, c0 + 2, cend, tid); scan_load<false>(s3, QD, KI, VV, DEC, offq, offd, c0 + 3, cend, tid);
    scan_store<false>(s0, L, lrow, lch, tid);
    __syncthreads();
#define PA_ITER(i, CUR, NXT) do { const int c = c0 + (i); \
        LAS unsigned char* B0 = L + ((i) & 1) * BUF; LAS unsigned char* B1 = L + (((i) & 1) ^ 1) * BUF; \
        scan_load<false>(CUR, QD, KI, VV, DEC, offq, offd, c + 4, cend, tid); \
        { const bf16x8 vb_ = SCAN_VFRAG(B0); SCAN_UPDATE(B0, vb_); } \
        if ((i) + 1 < 32) scan_store<false>(NXT, B1, lrow, lch, tid); \
        __syncthreads(); } while (0)
#pragma unroll
    for (int i4 = 0; i4 < 32; i4 += 4) { PA_ITER(i4, s0, s1); PA_ITER(i4 + 1, s1, s2); PA_ITER(i4 + 2, s2, s3); PA_ITER(i4 + 3, s3, s0); }
#undef PA_ITER
    if (seg < 3) {
#pragma unroll
        for (int kt = 0; kt < 8; ++kt) *(GAS f32x4*)(SL + (((size_t)(bh * 3 + seg) * 8 + kt) * 512 + tid) * 4) = S[kt]; }
}
__device__ __forceinline__ void hgrn_passB(LAS unsigned char* L, const bf16* QD, const bf16* KI, const bf16* VV, const bf16* GG, const float* DEC, const float* SL, const bf16* AT, const float* DP,
                                           const float* ngh, bf16* Uo, int tid, int wave, int lane) {
    constexpr int PITCH = 288, TB = 32 * PITCH, BUF = 28672, DOFF = 3 * TB, SSOFF = 2 * BUF;
    const int bh = blockIdx.x >> 2, seg = blockIdx.x & 3, b = bh >> 3, h = bh & 7, fr = lane & 15, g = lane >> 4, q4 = fr >> 2, p4 = fr & 3;
    const unsigned rowbase = (unsigned)b * SEQ * D + h * HD;
    const int lrow = tid >> 4, lch = tid & 15, c0 = seg * 32, cend = c0 + 32;
    const unsigned offq = (rowbase + lrow * D + lch * 8) * 2u, offd = ((unsigned)(b * 128) * D + h * HD + tid * 4) * 4u, offa = ((unsigned)(bh * 128) * 64 + lane) * 32u, offg = (rowbase + fr * D + 16 * wave + 4 * g) * 2u;
    ScanSet s0, s1, s2, s3;
    scan_load<true>(s0, QD, KI, VV, DEC, offq, offd, c0, cend, tid); scan_load<true>(s1, QD, KI, VV, DEC, offq, offd, c0 + 1, cend, tid);
    scan_load<true>(s2, QD, KI, VV, DEC, offq, offd, c0 + 2, cend, tid); scan_load<true>(s3, QD, KI, VV, DEC, offq, offd, c0 + 3, cend, tid);
    ScanAux xa, xb; aux_load(xa, GG, AT, offg, offa, c0, cend); xb = xa;
    f32x4 S[8];
#pragma unroll
    for (int kt = 0; kt < 8; ++kt) S[kt] = (f32x4){0.f, 0.f, 0.f, 0.f};
    if (seg >= 1) {
#pragma unroll
        for (int kt = 0; kt < 8; ++kt) S[kt] = *(const GAS f32x4*)(SL + (((size_t)(bh * 3 + 0) * 8 + kt) * 512 + tid) * 4);
        for (int i = 1; i < seg; ++i) {
#pragma unroll
            for (int kt = 0; kt < 8; ++kt) { const f32x4 dv = *(const GAS f32x4*)(DP + (size_t)(bh * 3 + i) * 128 + 16 * kt + 4 * g), lv = *(const GAS f32x4*)(SL + (((size_t)(bh * 3 + i) * 8 + kt) * 512 + tid) * 4);
                S[kt] = S[kt] * dv + lv; } }
    }
    scan_store<true>(s0, L, lrow, lch, tid);
    __syncthreads();
    const f32x4 ngv = *(const GAS f32x4*)(ngh + h * HD + 16 * wave + 4 * g);
#define PB_ITER(i, CUR, NXT, XC, XN) do { const int c = c0 + (i); \
        LAS unsigned char* B0 = L + ((i) & 1) * BUF; LAS unsigned char* B1 = L + (((i) & 1) ^ 1) * BUF; \
        const v2u gt0 = XC.g0, gt1 = XC.g1; \
        aux_load(XN, GG, AT, offg, offa, c + 1, cend); \
        scan_load<true>(CUR, QD, KI, VV, DEC, offq, offd, c + 4, cend, tid); \
        f32x4 o[2] = {(f32x4){0.f, 0.f, 0.f, 0.f}, (f32x4){0.f, 0.f, 0.f, 0.f}}; f32x4 a00 = {0.f, 0.f, 0.f, 0.f}, a01 = {0.f, 0.f, 0.f, 0.f}, a11 = {0.f, 0.f, 0.f, 0.f}; \
        _Pragma("unroll") for (int ks = 0; ks < 4; ++ks) { const bf16x8 sf = pack_f8(S[2 * ks], S[2 * ks + 1]); \
            LAS const unsigned char* p = B0 + fr * 272 + (32 * ks + 4 * g) * 2; LAS const unsigned char* pk_ = B0 + TB + fr * PITCH + (32 * ks + 4 * g) * 2; \
            const bf16x8 q0 = cat4(*(LAS const s16x4*)p, *(LAS const s16x4*)(p + 32)), q1 = cat4(*(LAS const s16x4*)(p + 16 * 272), *(LAS const s16x4*)(p + 16 * 272 + 32)); \
            const bf16x8 k0 = cat4(*(LAS const s16x4*)pk_, *(LAS const s16x4*)(pk_ + 32)), k1 = cat4(*(LAS const s16x4*)(pk_ + 16 * PITCH), *(LAS const s16x4*)(pk_ + 16 * PITCH + 32)); \
            o[0] = MFMA16(sf, q0, o[0]); o[1] = MFMA16(sf, q1, o[1]); a00 = MFMA16(k0, q0, a00); a01 = MFMA16(k0, q1, a01); a11 = MFMA16(k1, q1, a11); } \
        _Pragma("unroll") for (int r = 0; r < 4; ++r) if (4 * g + r > fr) { a00[r] = 0.f; a11[r] = 0.f; } \
        const bf16x8 pf0 = pack_f8(a00, (f32x4){0.f, 0.f, 0.f, 0.f}), pf1 = pack_f8(a01, a11); \
        { const bf16x8 vf = SCAN_VFRAG(B0); o[0] = MFMA16(vf, pf0, o[0]); o[1] = MFMA16(vf, pf1, o[1]); SCAN_UPDATE(B0, vf); } \
        _Pragma("unroll") for (int ct = 0; ct < 2; ++ct) { float ss = o[ct][0] * o[ct][0] + o[ct][1] * o[ct][1] + o[ct][2] * o[ct][2] + o[ct][3] * o[ct][3]; ss += __shfl_xor(ss, 16); ss += __shfl_xor(ss, 32); \
            if (g == 0) *(LAS float*)(L + SSOFF + (((i) & 1) * 32 + 16 * ct + fr) * 32 + wave * 4) = ss; } \
        if ((i) + 1 < 32) scan_store<true>(NXT, B1, lrow, lch, tid); \
        __syncthreads(); \
        _Pragma("unroll") for (int ct = 0; ct < 2; ++ct) { LAS const unsigned char* sp = L + SSOFF + (((i) & 1) * 32 + 16 * ct + fr) * 32; const f32x4 t0 = *(LAS const f32x4*)sp, t1 = *(LAS const f32x4*)(sp + 16); \
            const float tot = ((t0[0] + t0[1]) + (t0[2] + t0[3])) + ((t1[0] + t1[1]) + (t1[2] + t1[3])); \
            const float rstd = __builtin_amdgcn_rsqf(tot * (1.0f / HD) + EPS); const v2u gt = ct ? gt1 : gt0; \
            f32x4 r; r[0] = o[ct][0] * rstd * ngv[0] * bflo(gt.x); r[1] = o[ct][1] * rstd * ngv[1] * bfhi(gt.x); r[2] = o[ct][2] * rstd * ngv[2] * bflo(gt.y); r[3] = o[ct][3] * rstd * ngv[3] * bfhi(gt.y); \
            GST(v2u, Uo, offg + (unsigned)c * 65536u + (unsigned)ct * 32768u) = pg8::pack4_c(r); } \
    } while (0)
#pragma unroll
    for (int i4 = 0; i4 < 32; i4 += 4) { PB_ITER(i4, s0, s1, xa, xb); PB_ITER(i4 + 1, s1, s2, xb, xa); PB_ITER(i4 + 2, s2, s3, xa, xb); PB_ITER(i4 + 3, s3, s0, xb, xa); }
#undef PB_ITER
}

#define ATT_DECODE(un_, uu_, b_, h_, r_, n_) const int un_ = blockIdx.x * 8 + (uu_), b_ = un_ >> 8, h_ = (un_ >> 5) & 7, r_ = (un_ & 31) >> (5 - lg), n_ = (un_ & 31) & ((32 >> lg) - 1)
__device__ __forceinline__ void attn_group(LAS unsigned char* L, const bf16* Q, const bf16* K, const bf16* V, bf16* ORUN, float* LSE, const int lg, int tid, int wave, int lane) {
    constexpr int KP = 272, VP = 288, VOFF = 256 * KP; const bool first = (lg == 0);
    const int fr = lane & 15, g = lane >> 4, q4 = fr >> 2, p4 = fr & 3, lk = tid >> 4, ch = tid & 15;
    const float NEG = -__builtin_inff();
    v4u ck[4], cv[4]; bf16x8 qn[4];
    { ATT_DECODE(ua, 0, b, h, r, n);
      { const size_t qrow0 = (size_t)(b * SEQ + ((128 * n + 16 * wave + fr) << lg) + r);
#pragma unroll
        for (int ks = 0; ks < 4; ++ks) qn[ks] = *(const GAS bf16x8*)(Q + qrow0 * D + h * HD + 32 * ks + 8 * g); }
#pragma unroll
      for (int pass = 0; pass < 4; ++pass) { const size_t src = (size_t)(b * SEQ + ((128 * n + pass * 32 + lk) << lg) + r) * D + h * HD + ch * 8; ck[pass] = *(const GAS v4u*)(K + src); cv[pass] = *(const GAS v4u*)(V + src); } }
#pragma unroll 1
    for (int uu = 0; uu < 8; ++uu) {
        ATT_DECODE(ub, uu, b, h, r, n);
        const int flip = ((uu & 1) ^ 1) << 7;
        __syncthreads();
#pragma unroll
        for (int pass = 0; pass < 4; ++pass) { const int pk = (128 + pass * 32 + lk) ^ flip; *(LAS v4u*)(L + pk * KP + ch * 16) = ck[pass]; *(LAS v4u*)(L + VOFF + pk * VP + ch * 16) = cv[pass]; }
        if (n == 0) {
#pragma unroll
            for (int pass = 0; pass < 4; ++pass) { const int pk = (pass * 32 + lk) ^ flip; *(LAS v4u*)(L + VOFF + pk * VP + ch * 16) = (v4u){0, 0, 0, 0}; }
        } else if (uu == 0) {
#pragma unroll
            for (int pass = 0; pass < 4; ++pass) { const int kk = pass * 32 + lk, pk = kk ^ flip; const size_t src = (size_t)(b * SEQ + ((128 * (n - 1) + kk) << lg) + r) * D + h * HD + ch * 8;
                *(LAS v4u*)(L + pk * KP + ch * 16) = *(const GAS v4u*)(K + src); *(LAS v4u*)(L + VOFF + pk * VP + ch * 16) = *(const GAS v4u*)(V + src); }
        }
        const int qi = 16 * wave + fr; const size_t qrow = (size_t)(b * SEQ + ((128 * n + qi) << lg) + r);
        bf16x8 qf[4];
#pragma unroll
        for (int ks = 0; ks < 4; ++ks) qf[ks] = qn[ks];
        __syncthreads();
        if (uu + 1 < 8) { ATT_DECODE(uc, uu + 1, b2, h2, r2, n2);
            { const size_t qrow2 = (size_t)(b2 * SEQ + ((128 * n2 + 16 * wave + fr) << lg) + r2);
#pragma unroll
              for (int ks = 0; ks < 4; ++ks) qn[ks] = *(const GAS bf16x8*)(Q + qrow2 * D + h2 * HD + 32 * ks + 8 * g); }
#pragma unroll
            for (int pass = 0; pass < 4; ++pass) { const size_t src = (size_t)(b2 * SEQ + ((128 * n2 + pass * 32 + lk) << lg) + r2) * D + h2 * HD + ch * 8; ck[pass] = *(const GAS v4u*)(K + src); cv[pass] = *(const GAS v4u*)(V + src); } }
        const int kt0 = (16 * wave < 96) ? 16 * wave : 96;
        f32x4 s[10];
#pragma unroll
        for (int t = 0; t < 10; ++t) { s[t] = (f32x4){0.f, 0.f, 0.f, 0.f}; const int ki0 = kt0 + 16 * t, rowb = (ki0 ^ flip) + fr;
            const bool none = (ki0 + 15 < 16 * wave) || (ki0 > 16 * wave + 143) || (n == 0 && ki0 < 128);
            if (!none) {
#pragma unroll
                for (int ks = 0; ks < 4; ++ks) { const bf16x8 a = *(LAS const bf16x8*)(L + rowb * KP + ks * 64 + g * 16); s[t] = MFMA16(a, qf[ks], s[t]); } } }
        bf16* op = ORUN + qrow * D + h * HD + 4 * g;
        float lo = 0.f; v2u pr[8];
        if (!first) { lo = ((const GAS float*)LSE)[qrow * 8 + h];
#pragma unroll
            for (int dt = 0; dt < 8; ++dt) pr[dt] = *(const GAS v2u*)(op + 16 * dt); }
        float mx = NEG;
#pragma unroll
        for (int t = 0; t < 10; ++t) { const int ki0 = kt0 + 16 * t;
            const bool none = (ki0 + 15 < 16 * wave) || (ki0 > 16 * wave + 143) || (n == 0 && ki0 < 128);
            const bool full = (ki0 >= 16 * wave + 16) && (ki0 <= 16 * wave + 112) && (n > 0 || ki0 >= 128);
            if (none) { s[t] = (f32x4){NEG, NEG, NEG, NEG}; }
            else if (full) { mx = fmaxf(fmaxf(mx, fmaxf(s[t][0], s[t][1])), fmaxf(s[t][2], s[t][3])); }
            else {
#pragma unroll
                for (int rg = 0; rg < 4; ++rg) { const int ki = ki0 + 4 * g + rg; const bool ok = (ki >= qi) && (ki <= qi + 128);
                    s[t][rg] = ok ? s[t][rg] : NEG; mx = fmaxf(mx, s[t][rg]); } } }
        mx = fmaxf(mx, __shfl_xor(mx, 16)); mx = fmaxf(mx, __shfl_xor(mx, 32));
        float z = 0.f; const float mxl = -mx * 1.4426950408889634f;
#pragma unroll
        for (int t = 0; t < 10; ++t)
#pragma unroll
            for (int rg = 0; rg < 4; ++rg) { const float p = __builtin_amdgcn_exp2f(__builtin_fmaf(s[t][rg], 1.4426950408889634f, mxl)); s[t][rg] = p; z += p; }
        z += __shfl_xor(z, 16); z += __shfl_xor(z, 32);
        f32x4 o[8];
#pragma unroll
        for (int dt = 0; dt < 8; ++dt) o[dt] = (f32x4){0.f, 0.f, 0.f, 0.f};
#pragma unroll
        for (int j = 0; j < 5; ++j) { const bf16x8 pf = pack_f8(s[2 * j], s[2 * j + 1]);
            const int r0 = ((kt0 + 32 * j) ^ flip) + 4 * g + q4, r1 = ((kt0 + 32 * j + 16) ^ flip) + 4 * g + q4;
#pragma unroll
            for (int dt = 0; dt < 8; ++dt) { const bf16x8 vf = cat4(tr_read(L + VOFF + r0 * VP + (16 * dt + 4 * p4) * 2), tr_read(L + VOFF + r1 * VP + (16 * dt + 4 * p4) * 2)); o[dt] = MFMA16(vf, pf, o[dt]); } }
        float lse = mx + __logf(z), w_new = 1.0f / z, w_old = 0.f;
        if (!first) { const float mm = fmaxf(lo, lse), e1 = __expf(lo - mm), e2 = __expf(lse - mm), den = e1 + e2; w_old = e1 / den; w_new = w_new * e2 / den; lse = mm + __logf(den); }
#pragma unroll
        for (int dt = 0; dt < 8; ++dt) { f32x4 rr = o[dt] * w_new;
            if (!first) { rr[0] += w_old * bflo(pr[dt].x); rr[1] += w_old * bfhi(pr[dt].x); rr[2] += w_old * bflo(pr[dt].y); rr[3] += w_old * bfhi(pr[dt].y); }
            *(GAS v2u*)(op + 16 * dt) = pg8::pack4_c(rr); }
        if (g == 0 && lg < 4) ((GAS float*)LSE)[qrow * 8 + h] = lse;
    }
}
#ifndef SKIP_HG
#define SKIP_HG 0
#endif
#ifndef SKIP_SCAN
#define SKIP_SCAN 0
#endif
#ifndef SKIP_ROPE
#define SKIP_ROPE 0
#endif
#ifndef SKIP_ATT
#define SKIP_ATT 0
#endif
#ifndef SKIP_SWI
#define SKIP_SWI 0
#endif
#ifndef SKIP_PLAIN
#define SKIP_PLAIN 0
#endif
#ifndef SKIP_P0
#define SKIP_P0 0
#endif


#ifndef PROBE
#define PROBE 0
#endif
#define PSCALE 0.25f
#if PROBE
#define TS_INIT() do { if (blockIdx.x == 0 && threadIdx.x == 0) { for (int i_ = 0; i_ < 12; ++i_) *(LAS float*)(L + 144000 + 4 * i_) = 0.f; *(LAS unsigned long long*)(L + 144064) = __builtin_amdgcn_s_memrealtime(); } } while (0)
#define TS(cat) do { if (blockIdx.x == 0 && threadIdx.x == 0) { const unsigned long long t_ = __builtin_amdgcn_s_memrealtime(); const unsigned long long p_ = *(LAS unsigned long long*)(L + 144064); \
    *(LAS float*)(L + 144000 + 4 * (cat)) += (float)(t_ - p_) * 0.01f; *(LAS unsigned long long*)(L + 144064) = t_; } } while (0)
#else
#define TS_INIT() do {} while (0)
#define TS(cat) do {} while (0)
#endif
#define XB_TMO      128
#define XB_XCNT(j)  (256  + 64 * (j))
#define XB_XSUB(j)  (1280 + 64 * (j))
#define XB_XGEN(j)  (2304 + 64 * (j))
#define XB_TOP      3328
#define XB_TOPGEN   3392
#define XCD_BAR_WORDS 3456
#define XB_SPIN_CAP (1u << 18)

__device__ __forceinline__ unsigned xb_ld(unsigned* p)              { return __hip_atomic_load(p, __ATOMIC_RELAXED, __HIP_MEMORY_SCOPE_AGENT); }
__device__ __forceinline__ unsigned xb_add(unsigned* p, unsigned v) { return __hip_atomic_fetch_add(p, v, __ATOMIC_RELAXED, __HIP_MEMORY_SCOPE_AGENT); }
__device__ __forceinline__ unsigned xb_xcc_id() { return (unsigned)__builtin_amdgcn_s_getreg((3 << 11) | 20) & 0xFu; }
#define XB_SPIN(cond, bar) do { unsigned _sp = 0; while (cond) { __builtin_amdgcn_s_sleep(1); \
    if ((++_sp & 255u) == 0u) { if (xb_ld(&(bar)[XB_TMO])) break; if (_sp > XB_SPIN_CAP) { atomicAdd(&(bar)[XB_TMO], 1u); break; } } } } while (0)

struct XcdBarrier {
    unsigned* bar; unsigned x;
    volatile LAS unsigned* st;
};

__device__ __forceinline__ XcdBarrier xcd_barrier_post(unsigned* bar, volatile LAS unsigned* st) {
    XcdBarrier b; b.bar = bar; b.x = xb_xcc_id(); b.st = st;
    if (threadIdx.x == 0) (void)xb_add(&bar[XB_XCNT(b.x)], 1u);
    return b;
}
__device__ __forceinline__ void xcd_barrier_complete(unsigned* bar, unsigned x, unsigned& nloc, unsigned& nx) {
    const unsigned G = gridDim.x * gridDim.y * gridDim.z;
    unsigned sum, cnt, mine, sp = 0u;
    for (;;) {
        sum = 0u; cnt = 0u; mine = 0u;
#pragma unroll
        for (unsigned j = 0; j < 16; ++j) { const unsigned c = xb_ld(&bar[XB_XCNT(j)]); sum += c; cnt += (c > 0u) ? 1u : 0u; mine = (j == x) ? c : mine; }
        if (sum == G) break;
        __builtin_amdgcn_s_sleep(1);
        if ((++sp & 255u) == 0u) { if (xb_ld(&bar[XB_TMO])) break; if (sp > XB_SPIN_CAP) { atomicAdd(&bar[XB_TMO], 1u); break; } }
    }
    nloc = mine > 0u ? mine : 1u; nx = cnt > 0u ? cnt : 1u;
}

__device__ __forceinline__ void xcd_barrier(const XcdBarrier& b) {
    asm volatile("s_waitcnt vmcnt(0)" ::: "memory");
    __syncthreads();
    if (threadIdx.x == 0) {
        unsigned* bar = b.bar;
        __builtin_amdgcn_s_waitcnt(0);
        unsigned nloc = b.st[0], nx = b.st[1];
        if (nloc == 0u) { xcd_barrier_complete(bar, b.x, nloc, nx); b.st[0] = nloc; b.st[1] = nx; }
        const unsigned old = xb_add(&bar[XB_XSUB(b.x)], 1u);
        const unsigned gen = old / nloc;
        if (old + 1u == (gen + 1u) * nloc) {
            __builtin_amdgcn_fence(__ATOMIC_RELEASE, "agent");
            asm volatile("s_waitcnt vmcnt(0)" ::: "memory");
            const unsigned og = xb_add(&bar[XB_TOP], 1u);
            const unsigned tg = og / nx;
            if (og + 1u == (tg + 1u) * nx) xb_add(&bar[XB_TOPGEN], 1u);
            else XB_SPIN(xb_ld(&bar[XB_TOPGEN]) == tg, bar);
            __builtin_amdgcn_fence(__ATOMIC_ACQUIRE, "agent");
            xb_add(&bar[XB_XGEN(b.x)], 1u);
            asm volatile("s_waitcnt vmcnt(0)" ::: "memory");
        } else {
            XB_SPIN(xb_ld(&bar[XB_TOPGEN]) == gen, bar);
            __builtin_amdgcn_fence(__ATOMIC_ACQUIRE, "agent");
            asm volatile("s_waitcnt vmcnt(0)" ::: "memory");
        }
    }
    __syncthreads();
}

struct Args { const void* in[14]; float* out; unsigned char* ws; };
#define GEMM_PHASE(EpiT, Eobj, Aptr, Bptr, N_, K_) do { pg8::Gemm g_{(const pg8::bf16_t*)(Aptr), (const pg8::bf16_t*)(Bptr), M, (N_), (K_)}; pg8::StaticOrder S_; S_.init(M, (N_), G, (int)blockIdx.x); \
    pg8::gemm_phase<EpiT, pg8::StaticOrder, true, true>(L, g_, S_, Eobj); } while (0)

__device__ __forceinline__ unsigned char* opq(unsigned char* p) { asm volatile("" : "+s"(p)); return p; }
__device__ __forceinline__ const float* opqf(const void* p) { const float* q = (const float*)p; asm volatile("" : "+s"(q)); return q; }
__global__ void __launch_bounds__(NWAVES * 64, 2) fwd_kernel(Args a) {
    extern __shared__ __attribute__((aligned(16))) unsigned char lds_raw[];
    cg::grid_group grid = cg::this_grid();
    LAS unsigned char* L = (LAS unsigned char*)lds_raw;
    const int G = gridDim.x, NGW = G * NWAVES;
#define FRESH_IDS int tid = threadIdx.x; asm volatile("" : "+v"(tid)); const int lane = tid & 63, wave = __builtin_amdgcn_readfirstlane(tid >> 6), gw = blockIdx.x * NWAVES + wave; (void)lane; (void)wave; (void)gw;
#define WSB(off) (opq(a.ws) + (off))
#define MODP ((float*)WSB(WS_MOD))
#define LBP ((float*)WSB(WS_LB))
#define CSP ((float*)WSB(WS_ROPE))
#define SNP ((float*)WSB(WS_ROPE + (size_t)M * 16 * 4))
#define LSEP ((float*)WSB(WS_LSE))
#define UP ((bf16*)WSB(WS_U))
#define T0P ((bf16*)WSB(WS_R))
#define T1P ((bf16*)WSB(WS_R + 64 * MiB))
#define T2P ((bf16*)WSB(WS_R + 128 * MiB))
#define T3P ((bf16*)WSB(WS_R + 192 * MiB))
#define DECP ((float*)WSB(WS_R + 256 * MiB))
#define GSYNC() do { XcdBarrier xb_; xb_.bar = (unsigned*)opq(a.ws); xb_.x = xb_xcc_id(); xb_.st = (volatile LAS unsigned*)(L + 144128); xcd_barrier(xb_); } while (0)
    if (threadIdx.x < 2) ((LAS unsigned*)(L + 144128))[threadIdx.x] = 0u;
    __syncthreads();
    (void)xcd_barrier_post((unsigned*)opq(a.ws), (volatile LAS unsigned*)(L + 144128));
    TS_INIT();
    if (!SKIP_P0) { FRESH_IDS
        const float* cin = (const float*)a.in[1]; const int* pos = (const int*)a.in[2]; const float* ada_w = (const float*)a.in[3]; const float* ada_b = (const float*)a.in[4]; const float* lbraw = (const float*)a.in[7];
        float* MOD = MODP; float* LB = LBP; float* CS = CSP; float* SN = SNP; unsigned char* ws = a.ws;
        LAS float* condL = (LAS float*)L; LAS float* part = (LAS float*)(L + 32768);
        for (int i = tid; i < BATCH * D; i += NWAVES * 64) { const float v = cin[i]; condL[i] = v / (1.0f + expf(-v)); }
        __syncthreads();
        for (int item = blockIdx.x; item < 4 * 96; item += G) {
            const int l = item / 96, cc = item % 96, col = cc * 64 + lane;
            const float* wp = ada_w + ((size_t)l * D + wave * 128) * 6144 + col;
            float acc[8];
#pragma unroll
            for (int bb = 0; bb < 8; ++bb) acc[bb] = 0.f;
#pragma unroll 32
            for (int k = 0; k < 128; ++k) { const float w = ((const GAS float*)wp)[(size_t)k * 6144];
#pragma unroll
                for (int bb = 0; bb < 8; ++bb) acc[bb] += condL[bb * D + wave * 128 + k] * w; }
#pragma unroll
            for (int bb = 0; bb < 8; ++bb) part[(wave * 8 + bb) * 64 + lane] = acc[bb];
            __syncthreads();
            { const int bb = tid >> 6; float s = 0.f;
#pragma unroll
              for (int w2 = 0; w2 < 8; ++w2) s += part[(w2 * 8 + bb) * 64 + lane];
              MOD[(size_t)(l * 8 + bb) * 6144 + cc * 64 + lane] = s + ada_b[l * 6144 + cc * 64 + lane]; }
            __syncthreads();
        }
        if (blockIdx.x == 0) for (int i = tid; i < D; i += NWAVES * 64) { LB[i] = 0.f; LB[D + i] = 1.0f / (1.0f + expf(-(lbraw[D + i] - lbraw[i]))); }
        const float invf = (float)pow(500000.0, -(double)(tid & 15) / 16.0);
        for (int i = blockIdx.x * (NWAVES * 64) + tid; i < M * 16; i += G * NWAVES * 64) {
            const int m = i >> 4; const float ang = (float)pos[m] * invf;
            CS[i] = cosf(ang); SN[i] = sinf(ang); }
        __syncthreads();
        LAS float* scr = (LAS float*)(L + wave * 16640);
        for (int it0 = gw; it0 < 16128; it0 += NGW) { int it = it0;
            if (transpose_family(it, (const float*)a.in[6], 2, D, 4 * D, (bf16*)(ws + W_HIN), (size_t)4 * D * D, 1, scr, lane)) continue;
            if (transpose_family(it, (const float*)a.in[9], 2, D, D, (bf16*)(ws + W_HOUT), (size_t)D * D, 0, scr, lane)) continue;
            if (transpose_family(it, (const float*)a.in[10], 2, D, 9 * D, (bf16*)(ws + W_AIN), (size_t)9 * D * D, 0, scr, lane)) continue;
            if (transpose_family(it, (const float*)a.in[11], 2, D, D, (bf16*)(ws + W_AOUT), (size_t)D * D, 0, scr, lane)) continue;
            if (transpose_family(it, (const float*)a.in[12], 4, D, 2 * DFF, (bf16*)(ws + W_FIN), (size_t)2 * DFF * D, 2, scr, lane)) continue;
            transpose_family(it, (const float*)a.in[13], 4, DFF, D, (bf16*)(ws + W_FOUT), (size_t)DFF * D, 0, scr, lane);
        }
    }
    if (a.ws == nullptr) grid.sync();
    GSYNC();
    { FRESH_IDS const float* MOD = MODP; row_phase(a.in[0], true, nullptr, false, nullptr, nullptr, nullptr, UP, (const float*)a.in[5], MOD + 1024, MOD, gw, NGW, lane); }
    GSYNC(); TS(0);

#pragma unroll 1
    for (int l = 0; l < DEPTH; ++l) {
#pragma unroll 1
        for (int half = 0; half < 2; ++half) {
            const int idx = l >> 1;
            if (half == 0) {
                if ((l & 1) == 0) {
                    if (!SKIP_HG) { pg8::EpiHgrn E{T0P, T1P, T2P, T3P, DECP, LBP + idx * D}; GEMM_PHASE(pg8::EpiHgrn, E, UP, (bf16*)WSB(W_HIN) + (size_t)idx * 4 * D * D, 4 * D, D); }
                    GSYNC(); TS(1);
                    if (!SKIP_SCAN) { FRESH_IDS hgrn_passA(L, T0P, T1P, T2P, DECP, (float*)WSB(WS_SL), (bf16*)WSB(WS_AT), (float*)WSB(WS_DP), tid, wave, lane); }
                    GSYNC();
                    if (!SKIP_SCAN) { FRESH_IDS hgrn_passB(L, T0P, T1P, T2P, T3P, DECP, (const float*)WSB(WS_SL), (const bf16*)WSB(WS_AT), (const float*)WSB(WS_DP), opqf(a.in[8]) + idx * D, UP, tid, wave, lane); }
                } else {
#pragma unroll 1
                    for (int gi = 0; gi < 3; ++gi) {
                        if (!SKIP_ROPE) { pg8::EpiRope E{T0P, (size_t)M * D, CSP, SNP}; GEMM_PHASE(pg8::EpiRope, E, UP, (bf16*)WSB(W_AIN) + (size_t)idx * 9 * D * D + (size_t)gi * 3 * D * D, 3 * D, D); }
                        GSYNC(); TS(3);
                        if (!SKIP_ATT) { FRESH_IDS attn_group(L, T0P, T1P, T2P, T3P, LSEP, 2 * gi, tid, wave, lane); }
                        if (gi < 2) { GSYNC(); TS(4); }
                    }
                }
            } else {
                if (!SKIP_SWI) { pg8::EpiSwiglu E{T0P, DFF}; GEMM_PHASE(pg8::EpiSwiglu, E, UP, (bf16*)WSB(W_FIN) + (size_t)l * 2 * DFF * D, 2 * DFF, D); }
            }
            GSYNC(); if (half == 1) TS(7); else if (l & 1) TS(4); else TS(2);
            if (!SKIP_PLAIN) {
                const bf16* Ain = (half == 1) ? T0P : ((l & 1) ? T3P : UP);
                const bf16* Bout = (half == 1) ? (bf16*)WSB(W_FOUT) + (size_t)l * DFF * D : ((l & 1) ? (bf16*)WSB(W_AOUT) + (size_t)idx * D * D : (bf16*)WSB(W_HOUT) + (size_t)idx * D * D);
                pg8::EpiPlain E{(half == 1) ? T3P : T0P, D}; GEMM_PHASE(pg8::EpiPlain, E, Ain, Bout, D, (half == 1) ? DFF : D); }
            GSYNC(); if (half == 1) TS(8); else TS(5);
            { FRESH_IDS const float* modl = MODP + (size_t)l * 8 * 6144; const float* ngl = opqf(a.in[5]) + (size_t)l * 4 * D; float* out = a.out;
              if (half == 0) row_phase((l == 0) ? a.in[0] : (const void*)out, l == 0, out, false, T0P, modl + 2 * 1024, ngl + D, UP, ngl + 2 * D, modl + 4 * 1024, modl + 3 * 1024, gw, NGW, lane);
              else row_phase(out, false, out, l == DEPTH - 1, T3P, modl + 5 * 1024, ngl + 3 * D, (l < DEPTH - 1) ? UP : nullptr, ngl + 4 * D, modl + 8 * 6144 + 1024, modl + 8 * 6144, gw, NGW, lane); }
            if (!(l == DEPTH - 1 && half == 1)) { GSYNC(); TS(6); }
        }
    }
#if PROBE
    GSYNC(); TS(6);
    for (int i_ = 0; i_ < 10; ++i_) GSYNC();
    TS(9);
    if (blockIdx.x == 0) {
        __syncthreads();
        float va_ = 0.f;
#pragma unroll
        for (int c_ = 0; c_ < 10; ++c_) if ((PROBE >> c_) & 1) va_ += *(LAS float*)(L + 144000 + 4 * c_);
        if (threadIdx.x == 0) a.out[0] += va_ * PSCALE;
    }
#endif
}

extern "C" void kernel_launch(void* const* d_in, const int* in_sizes, int n_in, void* d_out, int out_size, void* d_ws, size_t ws_size, hipStream_t stream) {
    static int grid = 0;
    if (grid == 0) {
        if (n_in != 14 || out_size != M * D || ws_size < WS_END) { fprintf(stderr, "kernel_launch: unexpected shapes (n_in %d out %d ws %zu)\n", n_in, out_size, ws_size); grid = -1; return; }
        int dev = 0, cus = 0, per_cu = 0;
        if (hipGetDevice(&dev) != hipSuccess || hipDeviceGetAttribute(&cus, hipDeviceAttributeMultiprocessorCount, dev) != hipSuccess) { grid = -1; return; }
        if (hipFuncSetAttribute((const void*)fwd_kernel, hipFuncAttributeMaxDynamicSharedMemorySize, LDS_BYTES) != hipSuccess) { fprintf(stderr, "kernel_launch: hipFuncSetAttribute failed\n"); grid = -1; return; }
        if (hipOccupancyMaxActiveBlocksPerMultiprocessor(&per_cu, (const void*)fwd_kernel, NWAVES * 64, LDS_BYTES) != hipSuccess || per_cu < 1) { fprintf(stderr, "kernel_launch: occupancy query says %d\n", per_cu); (void)hipGetLastError(); per_cu = 1; }
        grid = cus;
        if (grid != 256) { fprintf(stderr, "kernel_launch: built for 256 CUs, device has %d\n", cus); grid = -1; return; }
    }
    if (grid < 0) return;
    if (hipMemsetAsync(d_ws, 0, 16384, stream) != hipSuccess) { fprintf(stderr, "kernel_launch: memset failed\n"); return; }
    Args a{};
    for (int i = 0; i < 14; ++i) a.in[i] = d_in[i];
    a.out = (float*)d_out; a.ws = (unsigned char*)d_ws;
    void* args[] = {&a};
    hipError_t e = hipLaunchCooperativeKernel((const void*)fwd_kernel, dim3(grid), dim3(NWAVES * 64), args, LDS_BYTES, stream);
    if (e != hipSuccess) fprintf(stderr, "kernel_launch: cooperative launch failed: %s\n", hipGetErrorString(e));
}
```
